# Optimizing an MI355X kernel written in HIP

```python
import math
import jax, jax.numpy as jnp
from jax import lax
import numpy as np

D_MODEL = 1024
BATCH = 2
SEQ = 16384
DEPTH = 2

GRID_W = 64
N_HEADS_A = 8
HEAD_DIM = 64
W_ATTN = N_HEADS_A * HEAD_DIM
WIN_H = 8
WIN_W = 16
N_BLOCKS_B = 8
BLOCK_W = 64
W_LRU = N_BLOCKS_B * BLOCK_W
CONV_W = 4
C_LRU = 8.0
SPLITS = (W_ATTN, W_ATTN, W_ATTN, W_ATTN, W_LRU, W_LRU, D_MODEL, D_MODEL)
D_IN = sum(SPLITS)
ALPHA = (2 * DEPTH) ** 0.25
BETA = (8 * DEPTH) ** -0.25
LN_EPS = 1e-5

kernel_name = "hybrid_natten_rglru_deepnorm_encoder"


def layer_norm(x, g, b):
    xf = x.astype(jnp.float32)
    mu = jnp.mean(xf, axis=-1, keepdims=True)
    var = jnp.mean(jnp.square(xf - mu), axis=-1, keepdims=True)
    y = (xf - mu) * lax.rsqrt(var + LN_EPS)
    return (y * g.astype(jnp.float32) + b.astype(jnp.float32)).astype(x.dtype)


def neighbourhood_attention(q, k, v, rpb):
    B, S, H, Dh = q.shape
    rows = S // GRID_W
    kh = min(WIN_H, rows)
    r = jnp.arange(rows)
    c = jnp.arange(GRID_W)
    rs = jnp.clip(r - kh // 2, 0, rows - kh)
    cs = jnp.clip(c - WIN_W // 2, 0, GRID_W - WIN_W)
    key_r = rs[:, None] + jnp.arange(kh)[None, :]
    key_c = cs[:, None] + jnp.arange(WIN_W)[None, :]
    dr = key_r - r[:, None] + (WIN_H - 1)
    dc = key_c - c[:, None] + (WIN_W - 1)
    n_keys = kh * WIN_W
    scale = Dh ** -0.5
    q_rows = (q * scale).reshape(B, rows, GRID_W, H, Dh).transpose(1, 0, 2, 3, 4)

    def row_fn(args):
        q_row, kr, drr = args
        idx = (kr[None, :, None] * GRID_W + key_c[:, None, :]).reshape(GRID_W, n_keys)
        k_g = k[:, idx]
        v_g = v[:, idx]
        bias = rpb[:, drr[:, None, None], dc[None, :, :]]
        bias = bias.transpose(0, 2, 1, 3).reshape(H, GRID_W, n_keys).astype(jnp.float32)
        s = jnp.einsum('bqhd,bqnhd->bhqn', q_row, k_g).astype(jnp.float32) + bias[None]
        p = jax.nn.softmax(s, axis=-1).astype(v.dtype)
        return jnp.einsum('bhqn,bqnhd->bqhd', p, v_g)

    o = lax.map(row_fn, (q_rows, key_r, dr))
    return o.transpose(1, 0, 2, 3, 4).reshape(B, S, H * Dh)


def centred_depthwise_conv(u, w, b):
    S = u.shape[1]
    left = CONV_W // 2
    up = jnp.pad(u, ((0, 0), (left, CONV_W - 1 - left), (0, 0)))
    out = sum(up[:, j:j + S] * w[j] for j in range(CONV_W))
    return out + b


def _lin_combine(e1, e2):
    a1, b1 = e1
    a2, b2 = e2
    return a1 * a2, a2 * b1 + b2


def rg_lru(x, w_gate, b_gate, lam, reverse):
    B, S, W = x.shape
    xb = x.reshape(B, S, N_BLOCKS_B, BLOCK_W)
    g = jnp.einsum('bsnd,gnde->gbsne', xb, w_gate) + b_gate[:, None, None]
    g = jax.nn.sigmoid(g.astype(jnp.float32)).reshape(2, B, S, W)
    r_gate, i_gate = g[0], g[1]
    log_a = -C_LRU * jax.nn.softplus(-lam.astype(jnp.float32)) * r_gate
    a = jnp.exp(log_a)
    mult = jnp.sqrt(-jnp.expm1(2.0 * log_a))
    first = S - 1 if reverse else 0
    pos = jnp.arange(S)[None, :, None]
    mult = jnp.where(pos == first, 1.0, mult)
    bx = mult * i_gate * x.astype(jnp.float32)
    _, h = lax.associative_scan(_lin_combine, (a, bx), axis=1, reverse=reverse)
    return h.astype(x.dtype)


def hybrid_layer(x, w_in, rpb, conv_w, conv_b, gate_w, gate_b, lam, w_ba, w_bb, b_merge, w_out, ln_g, ln_b):
    B, S, D = x.shape
    proj = x @ w_in
    offs = list(np.cumsum(SPLITS)[:-1])
    q, k, v, z_a, u, z_b, g_a, g_b = jnp.split(proj, offs, axis=-1)
    hs = (B, S, N_HEADS_A, HEAD_DIM)
    attn = neighbourhood_attention(q.reshape(hs), k.reshape(hs), v.reshape(hs), rpb)
    y_a = attn * jax.nn.silu(z_a)
    u = centred_depthwise_conv(u, conv_w, conv_b)
    h = rg_lru(u, gate_w[0], gate_b[0], lam[0], False) + rg_lru(u, gate_w[1], gate_b[1], lam[1], True)
    y_b = h * jax.nn.silu(z_b)
    m = jax.nn.sigmoid(g_a + b_merge[0]) * (y_a @ w_ba) + jax.nn.sigmoid(g_b + b_merge[1]) * (y_b @ w_bb)
    out = m @ w_out
    return layer_norm(ALPHA * x + out, ln_g, ln_b)


def setup_inputs(seed: int = 0) -> dict:
    key = jax.random.key(seed)
    ks = jax.random.split(key, 16)
    f32 = jnp.float32
    D = D_MODEL
    x = jax.random.normal(ks[0], (BATCH, SEQ, D), f32)
    emb_ln_g = 1.0 + 0.01 * jax.random.normal(ks[1], (D,), f32)
    emb_ln_b = 0.01 * jax.random.normal(ks[2], (D,), f32)
    w_in = jax.random.normal(ks[3], (DEPTH, D, D_IN), f32) * D ** -0.5
    rpb = 0.1 * jax.random.normal(ks[4], (DEPTH, N_HEADS_A, 2 * WIN_H - 1, 2 * WIN_W - 1), f32)
    conv_w = jax.random.normal(ks[5], (DEPTH, CONV_W, W_LRU), f32) * CONV_W ** -0.5
    conv_b = 0.01 * jax.random.normal(ks[6], (DEPTH, W_LRU), f32)
    lru_gate_w = jax.random.normal(ks[7], (DEPTH, 2, 2, N_BLOCKS_B, BLOCK_W, BLOCK_W), f32) * BLOCK_W ** -0.5
    lru_gate_b = 0.01 * jax.random.normal(ks[8], (DEPTH, 2, 2, N_BLOCKS_B, BLOCK_W), f32)
    a_c = jax.random.uniform(ks[9], (DEPTH, 2, W_LRU), f32, 0.9, 0.999)
    a_base = a_c ** (1.0 / C_LRU)
    lru_lambda = jnp.log(a_base) - jnp.log1p(-a_base)
    w_branch_attn = jax.random.normal(ks[10], (DEPTH, W_ATTN, D), f32) * (W_ATTN ** -0.5) * BETA
    w_branch_lru = jax.random.normal(ks[11], (DEPTH, W_LRU, D), f32) * (W_LRU ** -0.5) * BETA
    b_merge = 0.01 * jax.random.normal(ks[12], (DEPTH, 2, D), f32)
    w_out = jax.random.normal(ks[13], (DEPTH, D, D), f32) * (D ** -0.5) * BETA
    ln_g = 1.0 + 0.01 * jax.random.normal(ks[14], (DEPTH, D), f32)
    ln_b = 0.01 * jax.random.normal(ks[15], (DEPTH, D), f32)
    return {"x": x, "emb_ln_g": emb_ln_g, "emb_ln_b": emb_ln_b, "w_in": w_in, "rpb": rpb,
            "conv_w": conv_w, "conv_b": conv_b, "lru_gate_w": lru_gate_w, "lru_gate_b": lru_gate_b,
            "lru_lambda": lru_lambda, "w_branch_attn": w_branch_attn, "w_branch_lru": w_branch_lru,
            "b_merge": b_merge, "w_out": w_out, "ln_g": ln_g, "ln_b": ln_b}


def reference(x, emb_ln_g, emb_ln_b, w_in, rpb, conv_w, conv_b, lru_gate_w, lru_gate_b, lru_lambda,
              w_branch_attn, w_branch_lru, b_merge, w_out, ln_g, ln_b):
    h = layer_norm(x, emb_ln_g, emb_ln_b)
    for l in range(DEPTH):
        h = hybrid_layer(h, w_in[l], rpb[l], conv_w[l], conv_b[l], lru_gate_w[l], lru_gate_b[l],
                         lru_lambda[l], w_branch_attn[l], w_branch_lru[l], b_merge[l], w_out[l],
                         ln_g[l], ln_b[l])
    return h
```

```cpp
#include <hip/hip_runtime.h>
#include <hip/hip_cooperative_groups.h>
#include <cstdio>
#include <cstdint>
namespace cg = cooperative_groups;
#ifndef PROBE_ATTN
#define PROBE_ATTN 0
#endif
#ifndef PROBE_LRU
#define PROBE_LRU 0
#endif
#ifndef PROBE_GEMM
#define PROBE_GEMM 0
#endif

#define LAS __attribute__((address_space(3)))
typedef unsigned short bf16_t;
typedef short bf16x8 __attribute__((ext_vector_type(8)));
typedef float f32x4 __attribute__((ext_vector_type(4)));
typedef float f32x2 __attribute__((ext_vector_type(2)));
typedef unsigned u32x4 __attribute__((ext_vector_type(4)));
typedef unsigned u32x2 __attribute__((ext_vector_type(2)));

constexpr int T = 32768, D = 1024, SEQ = 16384, DIN = 5120, LDP = 4608, NL = 2;
constexpr int PC_Q = 0, PC_ZB = 512, PC_K = 1024, PC_ZA = 1536, PC_U = 2048, PC_G = 2560;
constexpr float ALPHA_F = 1.41421356237309515f;
constexpr float LN_EPS_F = 1e-5f;
constexpr int NCHUNK = 256;

constexpr size_t WS_WIN = 0;
constexpr size_t WS_WBR = WS_WIN + (size_t)NL * DIN * D * 2;
constexpr size_t WS_WOUT = WS_WBR + (size_t)NL * D * D * 2;
constexpr size_t WS_GW = WS_WOUT + (size_t)NL * D * D * 2;
constexpr size_t WS_SUMM = WS_GW + (size_t)NL * 2 * 2 * 8 * 64 * 64 * 2;
constexpr size_t WS_CARRY = WS_SUMM + (size_t)2 * 2 * 512 * NCHUNK * 8;
constexpr size_t WS_XB = WS_CARRY + (size_t)2 * 2 * NCHUNK * 512 * 4;
constexpr size_t WS_VT = WS_XB + (size_t)T * D * 2;
constexpr size_t WS_P = WS_VT + (size_t)512 * T * 2;
constexpr size_t WS_BAR = WS_P + (size_t)T * LDP * 2;
constexpr size_t WS_CNT = WS_BAR + 16384;
constexpr size_t WS_XCH = WS_CNT + (size_t)NL * 128 * 256;
constexpr size_t WS_STATS = WS_XCH + (size_t)T * 4 * 8;
constexpr size_t WS_KX = WS_STATS + (size_t)T * 8;
constexpr size_t WS_IDST = WS_KX + (size_t)T * 512 * 2;
constexpr size_t WS_STASH = WS_IDST + (size_t)T * 8 + 4 * D * 4;
constexpr size_t WS_END = WS_STASH + (size_t)T * 512 * 2;

constexpr int RING_BYTES = 131072, MISC_OFF = 131072, LDS_BYTES = 131072 + 16384;

__device__ __forceinline__ unsigned cvt_pk_bf16(float lo, float hi) { unsigned r; asm volatile("v_cvt_pk_bf16_f32 %0, %1, %2" : "=v"(r) : "v"(lo), "v"(hi)); return r; }
__device__ __forceinline__ float bf_lo(unsigned w) { return __uint_as_float(w << 16); }
__device__ __forceinline__ float bf_hi(unsigned w) { return __uint_as_float(w & 0xffff0000u); }
__device__ __forceinline__ float fast_rcp(float x) { return __builtin_amdgcn_rcpf(x); }
__device__ __forceinline__ float sigmoid_f(float x) { return fast_rcp(1.0f + __expf(-x)); }
__device__ __forceinline__ float silu_f(float x) { return x * sigmoid_f(x); }
__device__ __forceinline__ int lane_id() { int t; asm volatile("v_mbcnt_lo_u32_b32 %0, -1, 0\n\tv_mbcnt_hi_u32_b32 %0, -1, %0" : "=&v"(t)); return t; }
__device__ __forceinline__ int opaque_tid(int wv) { int t; asm volatile("v_mbcnt_lo_u32_b32 %0, -1, 0\n\tv_mbcnt_hi_u32_b32 %0, -1, %0\n\tv_lshl_or_b32 %0, %1, 6, %0" : "=&v"(t) : "s"(wv)); return t; }
template <int CTRL, int RMASK>
__device__ __forceinline__ float dpp_mov(float old_, float src) { return __int_as_float(__builtin_amdgcn_update_dpp(__float_as_int(old_), __float_as_int(src), CTRL, RMASK, 0xF, false)); }
__device__ __forceinline__ float wave_sum_dpp(float v) {
    v += dpp_mov<0xB1, 0xF>(v, v); v += dpp_mov<0x4E, 0xF>(v, v); v += dpp_mov<0x141, 0xF>(v, v); v += dpp_mov<0x140, 0xF>(v, v);
    v += dpp_mov<0x142, 0xA>(0.f, v); v += dpp_mov<0x143, 0xC>(0.f, v);
    return __int_as_float(__builtin_amdgcn_readlane(__float_as_int(v), 63));
}
__device__ __forceinline__ float bperm(float v, int src_lane) { return __int_as_float(__builtin_amdgcn_ds_bpermute(src_lane << 2, __float_as_int(v))); }
__device__ __forceinline__ float wave_sum(float v) {
#pragma unroll
    for (int o = 1; o < 64; o <<= 1) v += __shfl_xor(v, o);
    return v;
}

namespace pg8 {
constexpr int BM = 256, BK = 64, HALF = 128, HTB = HALF * BK * 2, STAGE_BYTES = 8 * HTB, NXCD = 8, WGM = 8;
__host__ __device__ __forceinline__ int lds_byte(int r, int c) { const int st = (r >> 4) * 2 + (c >> 5), rr = r & 15, cc = c & 31, ob = rr * 64 + cc * 2; return st * 1024 + (ob ^ (((ob >> 9) & 1) << 5)); }
__host__ __device__ __forceinline__ void stage_rc(int b, int& R, int& C) { const int st = b / 1024, sb = b % 1024, swz = sb ^ (((sb >> 9) & 1) << 5); R = (st >> 1) * 16 + swz / 64; C = (st & 1) * 32 + (swz % 64) / 2; }
__host__ __device__ __forceinline__ int perm32(int rho) { const int n = rho >> 4, i = rho & 15; return 8 * (i >> 2) + 4 * n + (i & 3); }
struct Unit { int pm, pn; };
struct Gemm { const bf16_t* A; const bf16_t* Bt; int M, N, K, lda, ldb; };
struct StaticOrder {
    int nM, nN, nwg, G, c;
    __device__ void init(int M, int N, int G_, int c_) { nM = M / BM; nN = N / BM; nwg = nM * nN; G = G_; c = c_; }
    __device__ bool next(int i, Unit& u) const {
        const long L = (long)i * G + c; if (L >= nwg) return false;
        int wgid = (int)L; { const int q = nwg / NXCD, r = nwg % NXCD, xcd = wgid % NXCD, off = wgid / NXCD; wgid = (xcd < r ? xcd * (q + 1) : r * (q + 1) + (xcd - r) * q) + off; }
        const int nig = WGM * nN, gid = wgid / nig, fm = gid * WGM, gsz = (nM - fm) < WGM ? (nM - fm) : WGM;
        u.pm = fm + ((wgid % nig) % gsz); u.pn = (wgid % nig) / gsz; return true;
    }
};
template <class Epi, int LDA, bool ALIGN_EPI = true>
__device__ __forceinline__ void gemm_phase(LAS unsigned char* lds, const Gemm g, const StaticOrder& S, const Epi& E, int wv) {
    const int tid = opaque_tid(wv), wid = __builtin_amdgcn_readfirstlane(tid >> 6), lane = tid & 63, wr = wid >> 2, wc = wid & 3, fr = lane & 15, fq = lane >> 4;
    constexpr int K = 1024, nt = K / BK, LDB = 1024;
    unsigned voffA[2], voffB[2];
#pragma unroll
    for (int i = 0; i < 2; ++i) { int R, C; stage_rc(tid * 16 + i * 8192, R, C); const int Rb = Epi::PERM ? ((R & ~31) + perm32(R & 31)) : R;
        voffA[i] = (unsigned)(R * LDA + C) * 2u; voffB[i] = (unsigned)(Rb * LDB + C) * 2u; }
    constexpr size_t kstep = (size_t)(BK * 2);
    constexpr size_t hstepA = (size_t)HALF * LDA * 2, hstepB = (size_t)HALF * LDB * 2;
    constexpr size_t tstepA = 2 * hstepA, tstepB = 2 * hstepB;
    const unsigned ldsw = (unsigned)wid * 1024u;
    const int aoff = lds_byte(wr * 64 + fr, fq * 8), boff = lds_byte(wc * 32 + fr, fq * 8);
#define PG8_SA(b, h) (((b) * 2 + (h)) * HTB)
#define PG8_SB(b, h) ((4 + (b) * 2 + (h)) * HTB)
#define PG8_STAGE(bufoff, gbase, voff) do { _Pragma("unroll") for (int _i = 0; _i < 2; ++_i) \
        __builtin_amdgcn_global_load_lds((const unsigned*)((const char*)(gbase) + (voff)[_i]), (LAS unsigned*)(lds + (bufoff) + ldsw + _i * 8192), 16, 0, 0); } while (0)
#define PG8_LDA(dst, b, h) do { _Pragma("unroll") for (int m = 0; m < 4; ++m) _Pragma("unroll") for (int k = 0; k < 2; ++k) dst[m][k] = *(const LAS bf16x8*)(lds + PG8_SA(b, h) + aoff + m * 2048 + k * 1024); } while (0)
#define PG8_LDB(dst, b, h) do { _Pragma("unroll") for (int n = 0; n < 2; ++n) _Pragma("unroll") for (int k = 0; k < 2; ++k) dst[n][k] = *(const LAS bf16x8*)(lds + PG8_SB(b, h) + boff + n * 2048 + k * 1024); } while (0)
#define PG8_MMA(ai, bj, At, Bt) do { __builtin_amdgcn_s_setprio(1); _Pragma("unroll") for (int m = 0; m < 4; ++m) _Pragma("unroll") for (int n = 0; n < 2; ++n) _Pragma("unroll") for (int k = 0; k < 2; ++k) \
        acc[ai][bj][m][n] = __builtin_amdgcn_mfma_f32_16x16x32_bf16(Bt[n][k], At[m][k], acc[ai][bj][m][n], 0, 0, 0); __builtin_amdgcn_s_setprio(0); } while (0)
#define PG8_WAIT_V(n) asm volatile("s_waitcnt vmcnt(" #n ")" ::: "memory")
#define PG8_WAIT_L(n) asm volatile("s_waitcnt lgkmcnt(" #n ")" ::: "memory")
#define PG8_BAR __builtin_amdgcn_s_barrier()
#define PG8_SCHED __builtin_amdgcn_sched_barrier(0)
    Unit cur, nxt; int ui = 0;
    if (!S.next(0, cur)) return;
    f32x4 acc[2][2][4][2];
#pragma unroll
    for (int a = 0; a < 2; ++a)
#pragma unroll
        for (int b = 0; b < 2; ++b)
#pragma unroll
            for (int m = 0; m < 4; ++m)
#pragma unroll
                for (int n = 0; n < 2; ++n) acc[a][b][m][n] = (f32x4){0.f, 0.f, 0.f, 0.f};
    bf16x8 At[4][2], B0[2][2], B1[2][2];
    const char* cA = (const char*)g.A + (size_t)cur.pm * tstepA; const char* cB = (const char*)g.Bt + (size_t)cur.pn * tstepB;
    PG8_STAGE(PG8_SB(0, 0), cB, voffB); PG8_STAGE(PG8_SB(0, 1), cB + hstepB, voffB); PG8_STAGE(PG8_SA(0, 0), cA, voffA); PG8_STAGE(PG8_SA(0, 1), cA + hstepA, voffA);
    if (wr == 1) PG8_BAR;
    PG8_WAIT_V(2); PG8_BAR;
    PG8_STAGE(PG8_SB(1, 0), cB + kstep, voffB); PG8_STAGE(PG8_SA(1, 0), cA + kstep, voffA); PG8_STAGE(PG8_SB(1, 1), cB + hstepB + kstep, voffB);
    PG8_WAIT_V(6); PG8_BAR;
    for (;;) {
        const bool has_next = S.next(ui + 1, nxt);
        const char* nA = has_next ? (const char*)g.A + (size_t)nxt.pm * tstepA : cA; const char* nB = has_next ? (const char*)g.Bt + (size_t)nxt.pn * tstepB : cB;
        for (int t = 0; t < nt; t += 2) {
            const bool last = (t == nt - 2);
            const char* a1 = cA + (size_t)(t + 1) * kstep;
            const char* a2 = last ? nA : cA + (size_t)(t + 2) * kstep; const char* b2 = last ? nB : cB + (size_t)(t + 2) * kstep;
            const char* a3 = a2 + kstep; const char* b3 = b2 + kstep;
            if constexpr (Epi::HAS_MID) { if (t == Epi::MID_T) E.mid(acc, cur, wr, wc, fr, fq); }
            PG8_LDB(B0, 0, 0); PG8_LDB(B1, 0, 1); PG8_SCHED; PG8_LDA(At, 0, 0); PG8_STAGE(PG8_SA(1, 1), a1 + hstepA, voffA);
            PG8_WAIT_V(8); PG8_WAIT_L(0); PG8_BAR; PG8_MMA(0, 0, At, B0); PG8_MMA(0, 1, At, B1); PG8_BAR; PG8_SCHED;
            PG8_LDA(At, 0, 1); PG8_STAGE(PG8_SB(0, 0), b2, voffB); PG8_STAGE(PG8_SB(0, 1), b2 + hstepB, voffB); PG8_STAGE(PG8_SA(0, 0), a2, voffA);
            PG8_WAIT_V(8); PG8_WAIT_L(0); PG8_BAR; PG8_MMA(1, 0, At, B0); PG8_MMA(1, 1, At, B1); PG8_BAR; PG8_SCHED;
            PG8_LDB(B0, 1, 0); PG8_LDB(B1, 1, 1); PG8_SCHED; PG8_LDA(At, 1, 0); PG8_STAGE(PG8_SA(0, 1), a2 + hstepA, voffA);
            PG8_WAIT_V(8); PG8_WAIT_L(0); PG8_BAR; PG8_MMA(0, 0, At, B0); PG8_MMA(0, 1, At, B1); PG8_BAR; PG8_SCHED;
            PG8_LDA(At, 1, 1); PG8_STAGE(PG8_SB(1, 0), b3, voffB); PG8_STAGE(PG8_SB(1, 1), b3 + hstepB, voffB); PG8_STAGE(PG8_SA(1, 0), a3, voffA);
            PG8_WAIT_V(8); PG8_WAIT_L(0); PG8_BAR; PG8_MMA(1, 0, At, B0); PG8_MMA(1, 1, At, B1); PG8_BAR; PG8_SCHED;
        }
        if constexpr (ALIGN_EPI) { if (wr == 0) PG8_BAR; }
        { int l2; asm volatile("v_mbcnt_lo_u32_b32 %0, -1, 0\n\tv_mbcnt_hi_u32_b32 %0, -1, %0" : "=&v"(l2));
          E(acc, cur, wr, wc, l2 & 15, l2 >> 4); }
        if (!has_next) break;
#pragma unroll
        for (int a = 0; a < 2; ++a)
#pragma unroll
            for (int b = 0; b < 2; ++b)
#pragma unroll
                for (int m = 0; m < 4; ++m)
#pragma unroll
                    for (int n = 0; n < 2; ++n) acc[a][b][m][n] = (f32x4){0.f, 0.f, 0.f, 0.f};
        cur = nxt; cA = nA; cB = nB; ++ui;
        if constexpr (ALIGN_EPI) { if (wr == 1) PG8_BAR; }
    }
    PG8_WAIT_V(0);
    if constexpr (!ALIGN_EPI) { if (wr == 0) PG8_BAR; }
    PG8_BAR;
#undef PG8_SA
#undef PG8_SB
#undef PG8_STAGE
#undef PG8_LDA
#undef PG8_LDB
#undef PG8_MMA
#undef PG8_WAIT_V
#undef PG8_WAIT_L
#undef PG8_BAR
#undef PG8_SCHED
}

__device__ __forceinline__ u32x4 pack8(f32x4 v0, f32x4 v1) { u32x4 w; w.x = cvt_pk_bf16(v0[0], v0[1]); w.y = cvt_pk_bf16(v0[2], v0[3]); w.z = cvt_pk_bf16(v1[0], v1[1]); w.w = cvt_pk_bf16(v1[2], v1[3]); return w; }

struct EpiIn {
    static constexpr bool PERM = true, HAS_MID = false; static constexpr int MID_T = 0, NVM = 16;
    bf16_t* P; const float* bm; bf16_t* KX;
    __device__ __forceinline__ void mid(f32x4 (&)[2][2][4][2], const Unit&, int, int, int, int) const {}
    __device__ __forceinline__ void operator()(const f32x4 (&acc)[2][2][4][2], const Unit& u, int wr, int wc, int fr, int fq) const {
        int row0 = u.pm * BM + wr * 64 + fr; asm volatile("" : "+v"(row0)); const int pn = u.pn;
        if (pn == 4 || pn == 5) {
#pragma unroll
            for (int bj = 0; bj < 2; ++bj) { const int c = (pn - 4) * BM + bj * HALF + wc * 32 + 8 * fq;
                bf16_t* kb = KX + ((size_t)((row0 >> 14) * 8 + (c >> 6)) * SEQ + (row0 & (SEQ - 1))) * 64 + (c & 63);
#pragma unroll
                for (int ai = 0; ai < 2; ++ai)
#pragma unroll
                    for (int m = 0; m < 4; ++m) *(u32x4*)(kb + (ai * HALF + m * 16) * 64) = pack8(acc[ai][bj][m][0], acc[ai][bj][m][1]); }
        } else if (pn < 10) {
            const bool act = (pn & 2) != 0;
            const int col0 = pn * BM + wc * 32 + 8 * fq;
#pragma unroll
            for (int ai = 0; ai < 2; ++ai)
#pragma unroll
                for (int m = 0; m < 4; ++m) { bf16_t* rowp = P + (size_t)(row0 + ai * HALF + m * 16) * LDP + col0;
#pragma unroll
                    for (int bj = 0; bj < 2; ++bj) { f32x4 v0 = acc[ai][bj][m][0], v1 = acc[ai][bj][m][1];
                        if (act) {
#pragma unroll
                            for (int j = 0; j < 4; ++j) { v0[j] = silu_f(v0[j]); v1[j] = silu_f(v1[j]); } }
                        *(u32x4*)(rowp + bj * HALF) = pack8(v0, v1); } }
        } else {
            const int j = pn - 10, gc = 128 * j + wc * 32 + 8 * fq;
            const f32x4 ba0 = *(const f32x4*)(bm + gc), ba1 = *(const f32x4*)(bm + gc + 4), bb0 = *(const f32x4*)(bm + 1024 + gc), bb1 = *(const f32x4*)(bm + 1024 + gc + 4);
            const int col0 = PC_G + 256 * j + wc * 32 + 8 * fq;
#pragma unroll
            for (int ai = 0; ai < 2; ++ai)
#pragma unroll
                for (int m = 0; m < 4; ++m) { bf16_t* rowp = P + (size_t)(row0 + ai * HALF + m * 16) * LDP + col0;
                    f32x4 ga0 = acc[ai][0][m][0] + ba0, ga1 = acc[ai][0][m][1] + ba1, gb0 = acc[ai][1][m][0] + bb0, gb1 = acc[ai][1][m][1] + bb1;
                    f32x4 r0, r1, s0, s1;
#pragma unroll
                    for (int q = 0; q < 4; ++q) {
                        const float ea0 = 1.0f + __expf(-ga0[q]), eb0 = 1.0f + __expf(-gb0[q]), ea1 = 1.0f + __expf(-ga1[q]), eb1 = 1.0f + __expf(-gb1[q]);
                        s0[q] = fast_rcp(eb0); s1[q] = fast_rcp(eb1); r0[q] = eb0 * fast_rcp(ea0); r1[q] = eb1 * fast_rcp(ea1); }
                    *(u32x4*)(rowp) = pack8(r0, r1); *(u32x4*)(rowp + HALF) = pack8(s0, s1); }
        }
    }
};
struct EpiPlain {
    static constexpr bool PERM = true, HAS_MID = false; static constexpr int MID_T = 0, NVM = 16;
    bf16_t* O; int ldc;
    __device__ __forceinline__ void mid(f32x4 (&)[2][2][4][2], const Unit&, int, int, int, int) const {}
    __device__ __forceinline__ void operator()(const f32x4 (&acc)[2][2][4][2], const Unit& u, int wr, int wc, int fr, int fq) const {
        int row0 = u.pm * BM + wr * 64 + fr; asm volatile("" : "+v"(row0)); const int col0 = u.pn * BM + wc * 32 + 8 * fq;
#pragma unroll
        for (int bj = 0; bj < 2; ++bj) { const int t = col0 + bj * HALF;
            bf16_t* vb = O + ((((size_t)((t >> 14) * 8 + (row0 >> 6)) * 256 + ((t >> 6) & 255)) * 64 + (row0 & 63)) * 64 + (t & 63));
#pragma unroll
            for (int ai = 0; ai < 2; ++ai)
#pragma unroll
                for (int m = 0; m < 4; ++m) *(u32x4*)(vb + (size_t)(2 * ai) * 256 * 4096 + m * 16 * 64) = pack8(acc[ai][bj][m][0], acc[ai][bj][m][1]); }
    }
};
struct EpiM {
    static constexpr bool PERM = true, HAS_MID = true; static constexpr int MID_T = 8, NVM = 16;
    const bf16_t* P; bf16_t* Mo;
    __device__ __forceinline__ void scale(f32x4 (&acc)[2][2][4][2], const Unit& u, int wr, int wc, int fr, int fq, int goff) const {
        int row0 = u.pm * BM + wr * 64 + fr; asm volatile("" : "+v"(row0));
#pragma unroll
        for (int ai = 0; ai < 2; ++ai) {
            u32x4 w[4][2];
#pragma unroll
            for (int m = 0; m < 4; ++m) { const bf16_t* rowp = P + (size_t)(row0 + ai * HALF + m * 16) * LDP + PC_G + goff + wc * 32 + 8 * fq;
#pragma unroll
                for (int bj = 0; bj < 2; ++bj) w[m][bj] = *(const u32x4*)(rowp + 256 * (2 * u.pn + bj)); }
            __builtin_amdgcn_sched_barrier(0);
#pragma unroll
            for (int m = 0; m < 4; ++m)
#pragma unroll
                for (int bj = 0; bj < 2; ++bj) { const u32x4 ww = w[m][bj];
                    f32x4& a0 = acc[ai][bj][m][0]; f32x4& a1 = acc[ai][bj][m][1];
                    a0[0] *= bf_lo(ww.x); a0[1] *= bf_hi(ww.x); a0[2] *= bf_lo(ww.y); a0[3] *= bf_hi(ww.y);
                    a1[0] *= bf_lo(ww.z); a1[1] *= bf_hi(ww.z); a1[2] *= bf_lo(ww.w); a1[3] *= bf_hi(ww.w); }
            __builtin_amdgcn_sched_barrier(0); }
    }
    __device__ __forceinline__ void mid(f32x4 (&acc)[2][2][4][2], const Unit& u, int wr, int wc, int fr, int fq) const { scale(acc, u, wr, wc, fr, fq, 0); }
    __device__ __forceinline__ void operator()(f32x4 (&acc)[2][2][4][2], const Unit& u, int wr, int wc, int fr, int fq) const {
        {
            int row0g = u.pm * BM + wr * 64 + fr; asm volatile("" : "+v"(row0g));
            u32x4 w[2][4][2];
#pragma unroll
            for (int ai = 0; ai < 2; ++ai)
#pragma unroll
                for (int m = 0; m < 4; ++m) { const bf16_t* rowp = P + (size_t)(row0g + ai * HALF + m * 16) * LDP + PC_G + HALF + wc * 32 + 8 * fq;
#pragma unroll
                    for (int bj = 0; bj < 2; ++bj) w[ai][m][bj] = *(const u32x4*)(rowp + 256 * (2 * u.pn + bj)); }
            asm volatile("" ::: "memory"); __builtin_amdgcn_sched_barrier(0);
#pragma unroll
            for (int ai = 0; ai < 2; ++ai)
#pragma unroll
                for (int m = 0; m < 4; ++m)
#pragma unroll
                    for (int bj = 0; bj < 2; ++bj) { const u32x4 ww = w[ai][m][bj];
                        f32x4& a0 = acc[ai][bj][m][0]; f32x4& a1 = acc[ai][bj][m][1];
                        a0[0] *= bf_lo(ww.x); a0[1] *= bf_hi(ww.x); a0[2] *= bf_lo(ww.y); a0[3] *= bf_hi(ww.y);
                        a1[0] *= bf_lo(ww.z); a1[1] *= bf_hi(ww.z); a1[2] *= bf_lo(ww.w); a1[3] *= bf_hi(ww.w); }
        }
        int row0 = u.pm * BM + wr * 64 + fr; asm volatile("" : "+v"(row0)); const int col0 = u.pn * BM + wc * 32 + 8 * fq;
#pragma unroll
        for (int ai = 0; ai < 2; ++ai)
#pragma unroll
            for (int m = 0; m < 4; ++m) { bf16_t* rowp = Mo + (size_t)(row0 + ai * HALF + m * 16) * D + col0;
#pragma unroll
                for (int bj = 0; bj < 2; ++bj) *(u32x4*)(rowp + bj * HALF) = pack8(acc[ai][bj][m][0], acc[ai][bj][m][1]); }
    }
};
struct EpiR {
    static constexpr bool PERM = false, HAS_MID = false; static constexpr int MID_T = 0, NVM = 32;
    const float* src; float* dst; const f32x2* stats; const float* g; const float* b;
    __device__ __forceinline__ void mid(f32x4 (&)[2][2][4][2], const Unit&, int, int, int, int) const {}
    __device__ __forceinline__ void operator()(const f32x4 (&acc)[2][2][4][2], const Unit& u, int wr, int wc, int fr, int fq) const {
        int row0 = u.pm * BM + wr * 64 + fr; asm volatile("" : "+v"(row0)); const int col0 = u.pn * BM + wc * 32 + 4 * fq;
        f32x4 gv[2][2], bv[2][2];
#pragma unroll
        for (int bj = 0; bj < 2; ++bj)
#pragma unroll
            for (int n = 0; n < 2; ++n) { gv[bj][n] = *(const f32x4*)(g + col0 + bj * HALF + n * 16) * ALPHA_F; bv[bj][n] = *(const f32x4*)(b + col0 + bj * HALF + n * 16) * ALPHA_F; }
#pragma unroll
        for (int ai = 0; ai < 2; ++ai)
#pragma unroll
            for (int mp = 0; mp < 2; ++mp) { f32x4 xr[2][2][2]; f32x2 st[2];
#pragma unroll
                for (int mi = 0; mi < 2; ++mi) { const int row = row0 + ai * HALF + (2 * mp + mi) * 16; st[mi] = stats[row]; const float* sp = src + (size_t)row * D + col0;
#pragma unroll
                    for (int bj = 0; bj < 2; ++bj)
#pragma unroll
                        for (int n = 0; n < 2; ++n) xr[mi][bj][n] = *(const f32x4*)(sp + bj * HALF + n * 16); }
                __builtin_amdgcn_sched_barrier(0);
#pragma unroll
                for (int mi = 0; mi < 2; ++mi) { const int row = row0 + ai * HALF + (2 * mp + mi) * 16; float* dp = dst + (size_t)row * D + col0;
#pragma unroll
                    for (int bj = 0; bj < 2; ++bj)
#pragma unroll
                        for (int n = 0; n < 2; ++n) *(f32x4*)(dp + bj * HALF + n * 16) = ((xr[mi][bj][n] - st[mi].x) * st[mi].y) * gv[bj][n] + bv[bj][n] + acc[ai][bj][2 * mp + mi][n]; }
                __builtin_amdgcn_sched_barrier(0); }
    }
};
struct EpiRF {
    static constexpr bool PERM = false, HAS_MID = false; static constexpr int MID_T = 0, NVM = 32; static constexpr bool RELAX = false;
    const float* xin; float* dst; unsigned char* ws; const float* lng; const float* lnb; int l; LAS unsigned char* misc;
    __device__ __forceinline__ void mid(f32x4 (&)[2][2][4][2], const Unit&, int, int, int, int) const {}
    __device__ __forceinline__ void operator()(f32x4 (&acc)[2][2][4][2], const Unit& u, int wr, int wc, int fr, int fq) const {
        const int tid = ((wr * 4 + wc) << 6) | (fq << 4) | fr;
        const float* src = (l == 0) ? xin : dst; const f32x2* stats = (const f32x2*)(ws + (l == 0 ? WS_STATS : WS_IDST));
        const float* g = (const float*)(ws + WS_IDST + (size_t)T * 8) + (l == 0 ? 2 * D : 0); const float* b = g + D;
        const float* g2 = lng + l * D; const float* b2 = lnb + l * D;
        unsigned long long* xch = (unsigned long long*)(ws + WS_XCH); unsigned* cnt = (unsigned*)(ws + WS_CNT) + (size_t)l * 128 * 64;
        bf16_t* dstb = (bf16_t*)(ws + WS_XB); const bool has_b = (l + 1 < NL);
        int row0 = u.pm * BM + wr * 64 + fr; asm volatile("" : "+v"(row0)); const int col0 = u.pn * BM + wc * 32 + 4 * fq;
        LAS f32x2* part = (LAS f32x2*)misc;
        LAS f32x2* stab = (LAS f32x2*)(misc + 8192);
        LAS float* aff = (LAS float*)(misc + 10240);
        const float affv = ((tid >> 8) ? b2 : g2)[u.pn * BM + (tid & 255)];
        const int lc0 = wc * 32 + 4 * fq;
#pragma unroll
        for (int ai = 0; ai < 2; ++ai) { float s1[4] = {0.f, 0.f, 0.f, 0.f}, s2[4] = {0.f, 0.f, 0.f, 0.f}; f32x2 st[4];
            int rb = row0 + ai * HALF; asm volatile("" : "+v"(rb));
#pragma unroll
            for (int m = 0; m < 4; ++m) st[m] = stats[rb + m * 16];
#pragma unroll
            for (int bj = 0; bj < 2; ++bj) { f32x4 xr[4][2], gv[2], bv[2];
#pragma unroll
                for (int n = 0; n < 2; ++n) { gv[n] = *(const f32x4*)(g + col0 + bj * HALF + n * 16); bv[n] = *(const f32x4*)(b + col0 + bj * HALF + n * 16); }
#pragma unroll
                for (int m = 0; m < 4; ++m)
#pragma unroll
                    for (int n = 0; n < 2; ++n) xr[m][n] = *(const f32x4*)(src + (size_t)(rb + m * 16) * D + col0 + bj * HALF + n * 16);
                asm volatile("" ::: "memory"); __builtin_amdgcn_sched_barrier(0);
                if (ai == 0 && bj == 0) aff[512 + tid] = affv;
#pragma unroll
                for (int m = 0; m < 4; ++m)
#pragma unroll
                    for (int n = 0; n < 2; ++n) { const f32x4 x = ((xr[m][n] - st[m].x) * st[m].y) * gv[n] + bv[n]; f32x4& a_ = acc[ai][bj][m][n];
#pragma unroll
                        for (int i = 0; i < 4; ++i) { const float v = __builtin_fmaf(x[i], ALPHA_F, a_[i]); a_[i] = v; s1[m] += v; s2[m] = __builtin_fmaf(v, v, s2[m]); } }
                asm volatile("" ::: "memory"); __builtin_amdgcn_sched_barrier(0); }
#pragma unroll
            for (int m = 0; m < 4; ++m) { float t1 = s1[m], t2 = s2[m];
                { const int ln_ = (fq << 4) | fr, a16 = (ln_ ^ 16) << 2, a32 = (ln_ ^ 32) << 2;
                  t1 += __int_as_float(__builtin_amdgcn_ds_bpermute(a16, __float_as_int(t1))); t1 += __int_as_float(__builtin_amdgcn_ds_bpermute(a32, __float_as_int(t1)));
                  t2 += __int_as_float(__builtin_amdgcn_ds_bpermute(a16, __float_as_int(t2))); t2 += __int_as_float(__builtin_amdgcn_ds_bpermute(a32, __float_as_int(t2))); }
                if (fq == 0) part[(ai * HALF + wr * 64 + m * 16 + fr) * 4 + wc] = (f32x2){t1, t2}; } }
        asm volatile("s_waitcnt lgkmcnt(0)" ::: "memory"); __builtin_amdgcn_s_barrier(); asm volatile("" ::: "memory");
        if (tid < 256) { const f32x2 a0 = part[tid * 4 + 0], a1 = part[tid * 4 + 1], a2 = part[tid * 4 + 2], a3 = part[tid * 4 + 3];
            const float S1 = (a0.x + a1.x) + (a2.x + a3.x), S2 = (a0.y + a1.y) + (a2.y + a3.y);
            const unsigned long long bits = ((unsigned long long)__float_as_uint(S2) << 32) | (unsigned long long)__float_as_uint(S1);
            __hip_atomic_store(xch + ((size_t)(u.pm * BM + tid)) * 4 + u.pn, bits, __ATOMIC_RELAXED, __HIP_MEMORY_SCOPE_AGENT); }
        asm volatile("s_waitcnt vmcnt(0)" ::: "memory"); __builtin_amdgcn_s_barrier(); asm volatile("" ::: "memory");
        if (tid == 0) {
            unsigned* c = cnt + 64 * u.pm;
            (void)__hip_atomic_fetch_add(c, 1u, __ATOMIC_RELAXED, __HIP_MEMORY_SCOPE_AGENT);
            unsigned sp = 0;
            while (__hip_atomic_load(c, __ATOMIC_RELAXED, __HIP_MEMORY_SCOPE_AGENT) < 4u) { __builtin_amdgcn_s_sleep(1); if (++sp > (1u << 22)) break; }
            __builtin_amdgcn_fence(__ATOMIC_ACQUIRE, "agent");
            asm volatile("s_waitcnt vmcnt(0)" ::: "memory");
        }
        asm volatile("" ::: "memory"); __builtin_amdgcn_s_barrier(); asm volatile("" ::: "memory");
        if (tid < 256) { float S1 = 0.f, S2 = 0.f;
#pragma unroll
            for (int k = 0; k < 4; ++k) { const unsigned long long bits = __hip_atomic_load(xch + ((size_t)(u.pm * BM + tid)) * 4 + k, __ATOMIC_RELAXED, __HIP_MEMORY_SCOPE_AGENT);
                S1 += __uint_as_float((unsigned)bits); S2 += __uint_as_float((unsigned)(bits >> 32)); }
            const float mean = S1 * (1.f / D), var = fmaxf(S2 * (1.f / D) - mean * mean, 0.f);
            stab[tid] = (f32x2){mean, 1.f / sqrtf(var + LN_EPS_F)}; }
        asm volatile("s_waitcnt lgkmcnt(0)" ::: "memory"); __builtin_amdgcn_s_barrier(); asm volatile("" ::: "memory");
        int l6 = tid & 63; asm volatile("" : "+v"(l6));
        const int fr6 = l6 & 15, lc6 = wc * 32 + 4 * (l6 >> 4), col6 = u.pn * BM + lc6;
#pragma unroll
        for (int ai = 0; ai < 2; ++ai) { f32x2 sn[4];
            const int rb = u.pm * BM + wr * 64 + fr6 + ai * HALF;
#pragma unroll
            for (int m = 0; m < 4; ++m) sn[m] = stab[ai * HALF + wr * 64 + m * 16 + fr6];
#pragma unroll
            for (int bj = 0; bj < 2; ++bj)
#pragma unroll
                for (int m = 0; m < 4; ++m)
#pragma unroll
                    for (int n = 0; n < 2; ++n) { const int lc = lc6 + bj * HALF + n * 16;
                        const f32x4 z = ((acc[ai][bj][m][n] - sn[m].x) * sn[m].y) * *(const LAS f32x4*)(aff + 512 + lc) + *(const LAS f32x4*)(aff + 768 + lc); const size_t off = (size_t)(rb + m * 16) * D + col6 + bj * HALF + n * 16;
                        *(f32x4*)(dst + off) = z;
                        if (has_b) { u32x2 w; w.x = cvt_pk_bf16(z[0], z[1]); w.y = cvt_pk_bf16(z[2], z[3]); *(u32x2*)(dstb + off) = w; } } }
        asm volatile("s_waitcnt lgkmcnt(0)" ::: "memory"); __builtin_amdgcn_s_barrier(); asm volatile("" ::: "memory");
    }
};
}

struct Params {
    const float *x, *emb_g, *emb_b, *w_in, *rpb, *conv_w, *conv_b, *gate_w, *gate_b, *lam, *w_ba, *w_bb, *b_merge, *w_out, *ln_g, *ln_b;
    float* out; unsigned char* ws;
};

__device__ __forceinline__ void transpose_item(const float* W, int ldw, int k0, int n0, bf16_t* dst, int ldd, float scale, LAS float* scr, int lane) {
    float v[32];
#pragma unroll
    for (int i = 0; i < 32; ++i) v[i] = W[(size_t)(k0 + 2 * i + (lane >> 5)) * ldw + n0 + (lane & 31)];
#pragma unroll
    for (int i = 0; i < 32; ++i) scr[(2 * i + (lane >> 5)) * 33 + (lane & 31)] = v[i];
    asm volatile("s_waitcnt lgkmcnt(0)" ::: "memory");
    const int c = lane & 7;
    float r[4][8];
#pragma unroll
    for (int j = 0; j < 4; ++j) { const LAS float* sp = scr + (8 * c) * 33 + (lane >> 3) + 8 * j;
#pragma unroll
        for (int q = 0; q < 8; ++q) r[j][q] = sp[q * 33]; }
#pragma unroll
    for (int j = 0; j < 4; ++j) { const int n = (lane >> 3) + 8 * j;
        u32x4 o; o.x = cvt_pk_bf16(r[j][0] * scale, r[j][1] * scale); o.y = cvt_pk_bf16(r[j][2] * scale, r[j][3] * scale);
        o.z = cvt_pk_bf16(r[j][4] * scale, r[j][5] * scale); o.w = cvt_pk_bf16(r[j][6] * scale, r[j][7] * scale);
        *(u32x4*)(dst + (size_t)n * ldd + 8 * c) = o; }
    asm volatile("s_waitcnt lgkmcnt(0)" ::: "memory");
}
__device__ __forceinline__ int win_dest_row(int n) {
    if (n < 512) return PC_Q + n;
    if (n < 1024) return PC_K + (n - 512);
    if (n < 1536) return LDP + (n - 1024);
    if (n < 2048) return PC_ZA + (n - 1536);
    if (n < 2560) return PC_U + (n - 2048);
    if (n < 3072) return PC_ZB + (n - 2560);
    if (n < 4096) { const int i = n - 3072; return PC_G + 256 * (i >> 7) + (i & 127); }
    { const int i = n - 4096; return PC_G + 256 * (i >> 7) + 128 + (i & 127); }
}
template <int R>
__device__ __forceinline__ void ln_rows(const float* xrow, size_t xstride, const float* g, const float* b, float* orow, bf16_t* brow, size_t ostride, f32x2* stats, int lane) {
    f32x4 v[R][4]; float s[R];
#pragma unroll
    for (int r = 0; r < R; ++r) { const f32x4* xr = (const f32x4*)(xrow + r * xstride) + lane; s[r] = 0.f;
#pragma unroll
        for (int j = 0; j < 4; ++j) v[r][j] = xr[64 * j]; }
#pragma unroll
    for (int r = 0; r < R; ++r)
#pragma unroll
        for (int j = 0; j < 4; ++j) s[r] += (v[r][j].x + v[r][j].y) + (v[r][j].z + v[r][j].w);
#pragma unroll
    for (int r = 0; r < R; ++r) s[r] = wave_sum_dpp(s[r]);
    float s2[R];
#pragma unroll
    for (int r = 0; r < R; ++r) { const float mean = s[r] * (1.f / D); s2[r] = 0.f;
#pragma unroll
        for (int j = 0; j < 4; ++j) { v[r][j] = v[r][j] - mean; s2[r] += (v[r][j].x * v[r][j].x + v[r][j].y * v[r][j].y) + (v[r][j].z * v[r][j].z + v[r][j].w * v[r][j].w); } }
#pragma unroll
    for (int r = 0; r < R; ++r) s2[r] = wave_sum_dpp(s2[r]);
    float rs_[R];
#pragma unroll
    for (int r = 0; r < R; ++r) { rs_[r] = 1.f / sqrtf(s2[r] * (1.f / D) + LN_EPS_F); if (stats && lane == 0) stats[r] = (f32x2){s[r] * (1.f / D), rs_[r]}; }
#pragma unroll
    for (int j = 0; j < 4; ++j) { const f32x4 gg = *((const f32x4*)g + lane + 64 * j), bb = *((const f32x4*)b + lane + 64 * j);
#pragma unroll
        for (int r = 0; r < R; ++r) { const float rstd = rs_[r];
            const f32x4 y = v[r][j] * rstd * gg + bb;
            if (orow) *((f32x4*)(orow + r * ostride) + lane + 64 * j) = y;
            if (brow) { u32x2 w; w.x = cvt_pk_bf16(y.x, y.y); w.y = cvt_pk_bf16(y.z, y.w); *((u32x2*)(brow + r * ostride) + lane + 64 * j) = w; } } }
}
__device__ __forceinline__ void p0_phase(const Params& p, LAS unsigned char* lds, int G, int wv) {
    const int tid = opaque_tid(wv), lane = tid & 63, wave = tid >> 6;
    LAS float* scr = (LAS float*)(lds + wave * 16384);
    const int gw = blockIdx.x * 8 + wave, NGW = G * 8;
    bf16_t* WIN = (bf16_t*)(p.ws + WS_WIN); bf16_t* WBR = (bf16_t*)(p.ws + WS_WBR); bf16_t* WOUT = (bf16_t*)(p.ws + WS_WOUT); bf16_t* GW = (bf16_t*)(p.ws + WS_GW);
    constexpr int I_IN = NL * 16 * 160, I_BR = NL * 8 * 32, I_OUT = NL * 16 * 32, I_GW = NL * 32 * 2;
    constexpr int NITEMS = I_IN + 2 * I_BR + I_OUT + I_GW;
    for (int it = gw; it < NITEMS; it += NGW) {
        int r = it;
        if (r < I_IN) { const int l = r / 2560, q = r % 2560, kb = q / 160, nb = q % 160, n0 = 32 * nb;
            transpose_item(p.w_in + (size_t)l * D * DIN, DIN, 64 * kb, n0, WIN + (size_t)l * DIN * D + (size_t)win_dest_row(n0) * D + 64 * kb, D, n0 < 512 ? 0.125f * 1.4426950408889634f : 1.0f, scr, lane); continue; }
        r -= I_IN;
        if (r < 2 * I_BR) { const int which = r / I_BR, q0 = r % I_BR, l = q0 / 256, q = q0 % 256, kb = q / 32, nb = q % 32;
            const float* W = (which ? p.w_bb : p.w_ba) + (size_t)l * 512 * D;
            transpose_item(W, D, 64 * kb, 32 * nb, WBR + (size_t)l * D * D + (size_t)(32 * nb) * D + which * 512 + 64 * kb, D, 1.0f, scr, lane); continue; }
        r -= 2 * I_BR;
        if (r < I_OUT) { const int l = r / 512, q = r % 512, kb = q / 32, nb = q % 32;
            transpose_item(p.w_out + (size_t)l * D * D, D, 64 * kb, 32 * nb, WOUT + (size_t)l * D * D + (size_t)(32 * nb) * D + 64 * kb, D, 1.0f, scr, lane); continue; }
        r -= I_OUT;
        { const int mat = r >> 1, nb = r & 1;
          transpose_item(p.gate_w + (size_t)mat * 4096, 64, 0, 32 * nb, GW + (size_t)mat * 4096 + (size_t)(32 * nb) * 64, 64, 1.0f, scr, lane); }
    }
    bf16_t* XB = (bf16_t*)(p.ws + WS_XB);
    { f32x2* ids = (f32x2*)(p.ws + WS_IDST); float* one = (float*)(p.ws + WS_IDST + (size_t)T * 8);
      for (int i2 = blockIdx.x * 512 + tid; i2 < T; i2 += G * 512) ids[i2] = (f32x2){0.f, 1.f};
      if (blockIdx.x == 0) for (int i2 = tid; i2 < 4 * D; i2 += 512) one[i2] = (i2 < D) ? 1.f : (i2 < 2 * D) ? 0.f : (i2 < 3 * D) ? p.emb_g[i2 - 2 * D] : p.emb_b[i2 - 3 * D]; }
    for (int m = 4 * gw; m < T; m += 4 * NGW) ln_rows<4>(p.x + (size_t)m * D, D, p.emb_g, p.emb_b, nullptr, XB + (size_t)m * D, D, (f32x2*)(p.ws + WS_STATS) + m, lane);
}
__device__ __forceinline__ void ln_phase(const Params& p, int l, int G, int wv) {
    const int tid = opaque_tid(wv), lane = tid & 63, wave = tid >> 6;
    const int gw = blockIdx.x * 8 + wave, NGW = G * 8;
    bf16_t* XB = (bf16_t*)(p.ws + WS_XB);
    const bool lastl = (l == NL - 1);
    for (int m = 4 * gw; m < T; m += 4 * NGW) ln_rows<4>(p.out + (size_t)m * D, D, p.ln_g + l * D, p.ln_b + l * D, lastl ? p.out + (size_t)m * D : nullptr, lastl ? nullptr : XB + (size_t)m * D, D, lastl ? nullptr : (f32x2*)(p.ws + WS_STATS) + m, lane);
}

constexpr int AT_K_OFF = 0, AT_V_OFF = 69120, AT_B_OFF = 138240, AT_NCH = 3840;
__device__ __forceinline__ void attn_decode(int unit, int& b, int& h, int& g, int& s) { g = unit & 3; s = (unit >> 2) & 31; h = (unit >> 7) & 7; b = unit >> 10; }
__device__ __forceinline__ void attn_issue(const bf16_t* KX, const bf16_t* VT, int unit, int tid, u32x4 (&kreg)[8], u32x4 (&vreg)[8]) {
    int b, h, g, s; attn_decode(unit, b, h, g, s);
    const int cb = (g == 0) ? 0 : (g == 1) ? 8 : (g == 2) ? 24 : 32;
    const int base = min(max(8 * s - 4, 0), 241);
#pragma unroll
    for (int it = 0; it < 8; ++it) { const int c = tid + 512 * it;
        if (c < AT_NCH) { const int row = c >> 8, rem = c & 255;
            kreg[it] = *(const u32x4*)(KX + ((size_t)(b * 8 + h) * SEQ + (base + row) * 64 + cb + (rem >> 3)) * 64 + 8 * (rem & 7));
            vreg[it] = *(const u32x4*)(VT + (((size_t)(b * 8 + h) * 256 + base + row) * 64 + (rem >> 2)) * 64 + cb + 8 * (rem & 3)); } }
}
__device__ __forceinline__ void attn_phase(const Params& p, int l, LAS unsigned char* lds, int G, int wv) {
    const int tid = opaque_tid(wv), lane = tid & 63, wid = tid >> 6, fr = lane & 15, fq = lane >> 4;
    bf16_t* P = (bf16_t*)(p.ws + WS_P); const bf16_t* VT = (const bf16_t*)(p.ws + WS_VT);
    LAS unsigned char* Kl = lds + AT_K_OFF; LAS unsigned char* Vl = lds + AT_V_OFF; LAS float* bl = (LAS float*)(lds + AT_B_OFF);
    u32x4 kreg[8], vreg[8];
    int unit = (G % 8 == 0) ? (int)(blockIdx.x & 7) * (G / 8) + (int)(blockIdx.x >> 3) : (int)blockIdx.x;
    asm volatile("" : "+s"(unit));
    const bf16_t* KX = (const bf16_t*)(p.ws + WS_KX);
    if (unit < 2048) attn_issue(KX, VT, unit, tid, kreg, vreg);
    for (; unit < 2048; unit += G) {
        int b, h, g, s; attn_decode(unit, b, h, g, s);
        const int cb = (g == 0) ? 0 : (g == 1) ? 8 : (g == 2) ? 24 : 32;
        const int base = min(max(8 * s - 4, 0), 241);
        const int r = 8 * s + wid, rs = min(max(r - 4, 0), 248), lr0 = rs - base;
        const int c = 16 * g + fr, cs = min(max(c - 8, 0), 48);
        const size_t tb = (size_t)b * SEQ, tq = tb + r * 64 + c;
        bf16x8 qf[2];
#pragma unroll
        for (int ks = 0; ks < 2; ++ks) qf[ks] = *(const bf16x8*)(P + tq * LDP + PC_Q + h * 64 + 32 * ks + 8 * fq);
        u32x2 zz[4];
#pragma unroll
        for (int dt = 0; dt < 4; ++dt) zz[dt] = *(const u32x2*)(P + tq * LDP + PC_ZA + h * 64 + 16 * dt + 4 * fq);
#pragma unroll
        for (int it = 0; it < 8; ++it) { const int ch = tid + 512 * it;
            if (ch < AT_NCH) { const int row = ch >> 8, rem = ch & 255;
                *(LAS u32x4*)(Kl + (row * 32 + (rem >> 3)) * 144 + (rem & 7) * 16) = kreg[it];
                LAS unsigned char* vd = Vl + (row * 64 + (rem >> 2)) * 72 + (rem & 3) * 16;
                *(LAS u32x2*)vd = (u32x2){vreg[it].x, vreg[it].y}; *(LAS u32x2*)(vd + 8) = (u32x2){vreg[it].z, vreg[it].w}; } }
        if (tid < 480) { const int drr = tid >> 5, cc = tid & 31; bl[tid] = (cc < 31) ? 1.4426950408889634f * p.rpb[(size_t)(l * 8 + h) * 465 + drr * 31 + cc] : -1e30f; }
        asm volatile("" :: "v"(qf[0]), "v"(qf[1]), "v"(zz[0]), "v"(zz[1]), "v"(zz[2]), "v"(zz[3]));
        __syncthreads();
        if (unit + G < 2048) attn_issue(KX, VT, unit + G, tid, kreg, vreg);
        f32x4 sc[8][2];
        bf16x8 kf[2][2][2][2];
        const LAS unsigned char* kbase = Kl + (lr0 * 32 + fr) * 144 + 16 * fq;
#define AT_LDK(buf, ip) do { _Pragma("unroll") for (int r_ = 0; r_ < 2; ++r_) _Pragma("unroll") for (int jt = 0; jt < 2; ++jt) { const LAS unsigned char* kp = kbase + ((2 * (ip) + r_) * 32 + 16 * jt) * 144; \
            kf[buf][r_][jt][0] = *(const LAS bf16x8*)kp; kf[buf][r_][jt][1] = *(const LAS bf16x8*)(kp + 64); } } while (0)
        AT_LDK(0, 0);
#pragma unroll
        for (int ip = 0; ip < 4; ++ip) {
            if (ip + 1 < 4) AT_LDK((ip + 1) & 1, ip + 1);
            __builtin_amdgcn_sched_barrier(0);
            __builtin_amdgcn_s_setprio(1);
#pragma unroll
            for (int r_ = 0; r_ < 2; ++r_)
#pragma unroll
                for (int jt = 0; jt < 2; ++jt) { f32x4 a = (f32x4){0.f, 0.f, 0.f, 0.f};
                    a = __builtin_amdgcn_mfma_f32_16x16x32_bf16(kf[ip & 1][r_][jt][0], qf[0], a, 0, 0, 0);
                    a = __builtin_amdgcn_mfma_f32_16x16x32_bf16(kf[ip & 1][r_][jt][1], qf[1], a, 0, 0, 0);
                    sc[2 * ip + r_][jt] = a; }
            __builtin_amdgcn_s_setprio(0);
            __builtin_amdgcn_sched_barrier(0);
        }
#undef AT_LDK
        const LAS float* bp[2][4];
#pragma unroll
        for (int jt = 0; jt < 2; ++jt)
#pragma unroll
            for (int q = 0; q < 4; ++q) { const int kc = cb + 16 * jt + 4 * fq + q; const bool valid = (kc >= cs) && (kc < cs + 16);
                bp[jt][q] = bl + (rs - r + 7) * 32 + (valid ? kc - c + 15 : 31); }
        float mx = -1e30f;
#pragma unroll
        for (int ih = 0; ih < 2; ++ih) {
            float bv_[4][2][4];
#pragma unroll
            for (int i = 0; i < 4; ++i)
#pragma unroll
                for (int jt = 0; jt < 2; ++jt)
#pragma unroll
                    for (int q = 0; q < 4; ++q) bv_[i][jt][q] = bp[jt][q][(4 * ih + i) * 32];
            __builtin_amdgcn_sched_barrier(0);
#pragma unroll
            for (int i = 0; i < 4; ++i)
#pragma unroll
                for (int jt = 0; jt < 2; ++jt)
#pragma unroll
                    for (int q = 0; q < 4; ++q) { const float v = sc[4 * ih + i][jt][q] + bv_[i][jt][q]; sc[4 * ih + i][jt][q] = v; mx = fmaxf(mx, v); }
        }
        mx = fmaxf(mx, bperm(mx, lane ^ 16)); mx = fmaxf(mx, bperm(mx, lane ^ 32));
        float sum = 0.f;
#pragma unroll
        for (int i = 0; i < 8; ++i)
#pragma unroll
            for (int jt = 0; jt < 2; ++jt)
#pragma unroll
                for (int q = 0; q < 4; ++q) { const float e = __builtin_amdgcn_exp2f(sc[i][jt][q] - mx); sc[i][jt][q] = e; sum += e; }
        sum += bperm(sum, lane ^ 16); sum += bperm(sum, lane ^ 32);
        const float inv = 1.0f / sum;
        f32x4 o[4];
#pragma unroll
        for (int dt = 0; dt < 4; ++dt) o[dt] = (f32x4){0.f, 0.f, 0.f, 0.f};
        u32x2 vr[2][4][2];
        const LAS unsigned char* vbase = Vl + (lr0 * 64 + fr) * 72 + 8 * fq;
#define AT_LDV(buf, i_) do { _Pragma("unroll") for (int dt = 0; dt < 4; ++dt) { const LAS unsigned char* vp = vbase + ((i_) * 64 + 16 * dt) * 72; \
            vr[buf][dt][0] = *(const LAS u32x2*)vp; vr[buf][dt][1] = *(const LAS u32x2*)(vp + 32); } } while (0)
        AT_LDV(0, 0);
#pragma unroll
        for (int i = 0; i < 8; ++i) {
            if (i + 1 < 8) AT_LDV((i + 1) & 1, i + 1);
            u32x4 pw; pw.x = cvt_pk_bf16(sc[i][0][0], sc[i][0][1]); pw.y = cvt_pk_bf16(sc[i][0][2], sc[i][0][3]); pw.z = cvt_pk_bf16(sc[i][1][0], sc[i][1][1]); pw.w = cvt_pk_bf16(sc[i][1][2], sc[i][1][3]);
            const bf16x8 pf = __builtin_bit_cast(bf16x8, pw);
            __builtin_amdgcn_sched_barrier(0);
            __builtin_amdgcn_s_setprio(1);
#pragma unroll
            for (int dt = 0; dt < 4; ++dt) {
                u32x4 vw; vw.x = vr[i & 1][dt][0].x; vw.y = vr[i & 1][dt][0].y; vw.z = vr[i & 1][dt][1].x; vw.w = vr[i & 1][dt][1].y;
                o[dt] = __builtin_amdgcn_mfma_f32_16x16x32_bf16(__builtin_bit_cast(bf16x8, vw), pf, o[dt], 0, 0, 0); }
            __builtin_amdgcn_s_setprio(0);
            __builtin_amdgcn_sched_barrier(0);
        }
#undef AT_LDV
#pragma unroll
        for (int dt = 0; dt < 4; ++dt) {
            const u32x2 z = zz[dt];
            u32x2 w; w.x = cvt_pk_bf16(o[dt][0] * inv * bf_lo(z.x), o[dt][1] * inv * bf_hi(z.x)); w.y = cvt_pk_bf16(o[dt][2] * inv * bf_lo(z.y), o[dt][3] * inv * bf_hi(z.y));
            *(u32x2*)(P + tq * LDP + PC_Q + h * 64 + 16 * dt + 4 * fq) = w; }
        __syncthreads();
    }
}

constexpr int LR_U_OFF = 0, LR_U_ROW = 1040, LR_HF_OFF = 67 * 1040, LR_CW_OFF = LR_HF_OFF + 65536, LR_END = LR_CW_OFF + 10240;
static_assert(LR_END <= LDS_BYTES - 16 && (LR_CW_OFF % 16) == 0 && (LR_HF_OFF % 16) == 0, "LRU LDS map");
__device__ __forceinline__ u32x2* stash_ptr(unsigned char* ws, int dir, int which, size_t blk, int lane) {
    if (dir == 0) return (u32x2*)(ws + WS_XB + (size_t)which * ((size_t)T * 512 * 2)) + blk * 64 + lane;
    if (which == 0) return (u32x2*)(ws + WS_STASH) + blk * 64 + lane;
    return (u32x2*)((bf16_t*)(ws + WS_P) + (blk >> 1) * LDP + PC_K + (blk & 1) * 256) + lane;
}
template <bool FINAL, int dir>
__device__ __forceinline__ void lru_sweep(const Params& p, int l, int unit, int n, int lane, const bf16_t* GW, const float* CARRY, f32x2* SUMM, LAS float* cw, LAS bf16_t* hf, LAS unsigned char* ul, const bf16x8 (&idf)[4]) {
    const int fr = lane & 15, fq = lane >> 4, b = unit >> 8, chunk = unit & 255;
    const size_t ub = ((size_t)unit * 8 + n) * 16;
    float h[4], At[4];
    if constexpr (!FINAL) {
        bf16x8 wf[2][4][2];
#pragma unroll
        for (int gm = 0; gm < 2; ++gm)
#pragma unroll
            for (int et = 0; et < 4; ++et)
#pragma unroll
                for (int ks = 0; ks < 2; ++ks) wf[gm][et][ks] = *(const bf16x8*)(GW + ((size_t)(((dir * 2 + gm) * 8 + n) * 64 + 16 * et + fr)) * 64 + 32 * ks + 8 * fq);
        float br[4], bi[4], ce[4];
        {   float g0[4], g1[4], lm[4];
#pragma unroll
            for (int et = 0; et < 4; ++et) { const int e = 64 * n + 16 * et + fr;
                g0[et] = p.gate_b[((l * 2 + dir) * 2 + 0) * 512 + e]; g1[et] = p.gate_b[((l * 2 + dir) * 2 + 1) * 512 + e]; lm[et] = p.lam[(l * 2 + dir) * 512 + e]; h[et] = 0.f; At[et] = 1.f; }
            __builtin_amdgcn_sched_barrier(0);
#pragma unroll
            for (int et = 0; et < 4; ++et) { br[et] = -1.4426950408889634f * g0[et]; bi[et] = -1.4426950408889634f * g1[et];
                ce[et] = -8.0f * 1.4426950408889634f * log1pf(__expf(-lm[et])); }
        }
#pragma unroll 1
        for (int tt = 0; tt < 4; ++tt) {
            const int tile = dir ? 3 - tt : tt;
            const int s0 = chunk * 64 + tile * 16;
            bf16x8 xf[2];
            LAS bf16x8* xcache = (LAS bf16x8*)hf + (tile * 2) * 64 + lane;
            if (dir == 0) {
#pragma unroll
                for (int ks = 0; ks < 2; ++ks) {
                    const int ch0 = 64 * n + 32 * ks + 8 * fq;
                    f32x4 a0 = *(const LAS f32x4*)(cw + 2048 + ch0), a1 = *(const LAS f32x4*)(cw + 2048 + ch0 + 4);
#pragma unroll
                    for (int tap = 0; tap < 4; ++tap) {
                        const u32x4 uw = *(const LAS u32x4*)(ul + (tile * 16 + fr + tap) * LR_U_ROW + ch0 * 2);
                        const f32x4 w0 = *(const LAS f32x4*)(cw + tap * 512 + ch0), w1 = *(const LAS f32x4*)(cw + tap * 512 + ch0 + 4);
                        a0[0] += bf_lo(uw.x) * w0[0]; a0[1] += bf_hi(uw.x) * w0[1]; a0[2] += bf_lo(uw.y) * w0[2]; a0[3] += bf_hi(uw.y) * w0[3];
                        a1[0] += bf_lo(uw.z) * w1[0]; a1[1] += bf_hi(uw.z) * w1[1]; a1[2] += bf_lo(uw.w) * w1[2]; a1[3] += bf_hi(uw.w) * w1[3]; }
                    xf[ks] = __builtin_bit_cast(bf16x8, pg8::pack8(a0, a1)); xcache[ks * 64] = xf[ks]; }
            } else { xf[0] = xcache[0]; xf[1] = xcache[64]; }
#pragma unroll
            for (int et = 0; et < 4; ++et) {
                if (et == 2) __builtin_amdgcn_sched_barrier(0);
                f32x4 gr = (f32x4){0.f, 0.f, 0.f, 0.f}, gi = gr, xc = gr;
                gr = __builtin_amdgcn_mfma_f32_16x16x32_bf16(xf[0], wf[0][et][0], gr, 0, 0, 0); gr = __builtin_amdgcn_mfma_f32_16x16x32_bf16(xf[1], wf[0][et][1], gr, 0, 0, 0);
                gi = __builtin_amdgcn_mfma_f32_16x16x32_bf16(xf[0], wf[1][et][0], gi, 0, 0, 0); gi = __builtin_amdgcn_mfma_f32_16x16x32_bf16(xf[1], wf[1][et][1], gi, 0, 0, 0);
                xc = __builtin_amdgcn_mfma_f32_16x16x32_bf16(xf[et >> 1], idf[et], xc, 0, 0, 0);
                float la[4], bx[4];
#pragma unroll
                for (int q = 0; q < 4; ++q) {
                    const float rg = fast_rcp(1.0f + __builtin_amdgcn_exp2f(__builtin_fmaf(gr[q], -1.4426950408889634f, br[et])));
                    const float ig = fast_rcp(1.0f + __builtin_amdgcn_exp2f(__builtin_fmaf(gi[q], -1.4426950408889634f, bi[et])));
                    la[q] = ce[et] * rg;
                    const float aq = __builtin_amdgcn_exp2f(la[q]);
                    float mult = __builtin_amdgcn_sqrtf(__builtin_fmaf(-aq, aq, 1.0f));
                    if (q == (dir ? 3 : 0)) { const int spos = s0 + 4 * fq + q; if (dir ? (spos == SEQ - 1) : (spos == 0)) mult = 1.0f; }
                    bx[q] = mult * ig * xc[q]; }
                u32x2 lw, bw; lw.x = cvt_pk_bf16(la[0], la[1]); lw.y = cvt_pk_bf16(la[2], la[3]); bw.x = cvt_pk_bf16(bx[0], bx[1]); bw.y = cvt_pk_bf16(bx[2], bx[3]);
                __builtin_nontemporal_store(lw, stash_ptr(p.ws, dir, 0, ub + tile * 4 + et, lane)); __builtin_nontemporal_store(bw, stash_ptr(p.ws, dir, 1, ub + tile * 4 + et, lane));
                float a[4];
                a[0] = __builtin_amdgcn_exp2f(bf_lo(lw.x)); a[1] = __builtin_amdgcn_exp2f(bf_hi(lw.x)); a[2] = __builtin_amdgcn_exp2f(bf_lo(lw.y)); a[3] = __builtin_amdgcn_exp2f(bf_hi(lw.y));
                bx[0] = bf_lo(bw.x); bx[1] = bf_hi(bw.x); bx[2] = bf_lo(bw.y); bx[3] = bf_hi(bw.y);
                const float A3 = (a[0] * a[1]) * (a[2] * a[3]);
                float B3;
                if (!dir) B3 = ((bx[0] * a[1] + bx[1]) * a[2] + bx[2]) * a[3] + bx[3];
                else B3 = ((bx[3] * a[2] + bx[2]) * a[1] + bx[1]) * a[0] + bx[0];
                float ag[4], bg[4];
#pragma unroll
                for (int k = 0; k < 4; ++k) { ag[k] = bperm(A3, 16 * k + fr); bg[k] = bperm(B3, 16 * k + fr); }
                if (!dir) { const float c0 = h[et], c1 = ag[0] * c0 + bg[0], c2 = ag[1] * c1 + bg[1], c3 = ag[2] * c2 + bg[2]; h[et] = ag[3] * c3 + bg[3]; }
                else { const float c3 = h[et], c2 = ag[3] * c3 + bg[3], c1 = ag[2] * c2 + bg[2], c0 = ag[1] * c1 + bg[1]; h[et] = ag[0] * c0 + bg[0]; }
                At[et] *= (ag[0] * ag[1]) * (ag[2] * ag[3]);
            }
        }
        if (fq == 0) {
#pragma unroll
            for (int et = 0; et < 4; ++et) SUMM[((size_t)((b * 2 + dir) * 512 + 64 * n + 16 * et + fr)) * NCHUNK + chunk] = (f32x2){At[et], h[et]}; }
    } else {
#pragma unroll
        for (int et = 0; et < 4; ++et) h[et] = CARRY[((size_t)((b * 2 + dir) * NCHUNK + chunk)) * 512 + 64 * n + 16 * et + fr];
        u32x2 nl[4], nb[4];
#pragma unroll
        for (int et = 0; et < 4; ++et) { const int t0 = dir ? 3 : 0; nl[et] = __builtin_nontemporal_load(stash_ptr(p.ws, dir, 0, ub + t0 * 4 + et, lane)); nb[et] = __builtin_nontemporal_load(stash_ptr(p.ws, dir, 1, ub + t0 * 4 + et, lane)); }
#pragma unroll 1
        for (int tt = 0; tt < 4; ++tt) {
            const int tile = dir ? 3 - tt : tt;
            u32x2 cl[4], cb[4];
#pragma unroll
            for (int et = 0; et < 4; ++et) { cl[et] = nl[et]; cb[et] = nb[et]; }
            if (tt + 1 < 4) { const int tn = dir ? tile - 1 : tile + 1;
#pragma unroll
                for (int et = 0; et < 4; ++et) { nl[et] = __builtin_nontemporal_load(stash_ptr(p.ws, dir, 0, ub + tn * 4 + et, lane)); nb[et] = __builtin_nontemporal_load(stash_ptr(p.ws, dir, 1, ub + tn * 4 + et, lane)); } }
#pragma unroll
            for (int et = 0; et < 4; ++et) {
                float a[4], bx[4];
                a[0] = __builtin_amdgcn_exp2f(bf_lo(cl[et].x)); a[1] = __builtin_amdgcn_exp2f(bf_hi(cl[et].x)); a[2] = __builtin_amdgcn_exp2f(bf_lo(cl[et].y)); a[3] = __builtin_amdgcn_exp2f(bf_hi(cl[et].y));
                bx[0] = bf_lo(cb[et].x); bx[1] = bf_hi(cb[et].x); bx[2] = bf_lo(cb[et].y); bx[3] = bf_hi(cb[et].y);
                const float A3 = (a[0] * a[1]) * (a[2] * a[3]);
                float B3;
                if (!dir) B3 = ((bx[0] * a[1] + bx[1]) * a[2] + bx[2]) * a[3] + bx[3];
                else B3 = ((bx[3] * a[2] + bx[2]) * a[1] + bx[1]) * a[0] + bx[0];
                float ag[4], bg[4];
#pragma unroll
                for (int k = 0; k < 4; ++k) { ag[k] = bperm(A3, 16 * k + fr); bg[k] = bperm(B3, 16 * k + fr); }
                float cin;
                if (!dir) { const float c0 = h[et], c1 = ag[0] * c0 + bg[0], c2 = ag[1] * c1 + bg[1], c3 = ag[2] * c2 + bg[2], c4 = ag[3] * c3 + bg[3];
                    cin = fq == 0 ? c0 : fq == 1 ? c1 : fq == 2 ? c2 : c3; h[et] = c4; }
                else { const float c3 = h[et], c2 = ag[3] * c3 + bg[3], c1 = ag[2] * c2 + bg[2], c0 = ag[1] * c1 + bg[1], cm = ag[0] * c0 + bg[0];
                    cin = fq == 3 ? c3 : fq == 2 ? c2 : fq == 1 ? c1 : c0; h[et] = cm; }
                float hv[4];
                if (!dir) { hv[0] = a[0] * cin + bx[0]; hv[1] = a[1] * hv[0] + bx[1]; hv[2] = a[2] * hv[1] + bx[2]; hv[3] = a[3] * hv[2] + bx[3]; }
                else { hv[3] = a[3] * cin + bx[3]; hv[2] = a[2] * hv[3] + bx[2]; hv[1] = a[1] * hv[2] + bx[1]; hv[0] = a[0] * hv[1] + bx[0]; }
#pragma unroll
                for (int q = 0; q < 4; ++q) { LAS bf16_t* hp = hf + (tile * 16 + 4 * fq + q) * 64 + 16 * et + fr;
                    float tot = hv[q]; if (dir) tot += __uint_as_float(((unsigned)*hp) << 16);
                    *hp = (bf16_t)(cvt_pk_bf16(tot, 0.f) & 0xffffu); }
            }
        }
    }
}
template <bool FINAL>
__device__ __forceinline__ void lru_phase(const Params& p, int l, LAS unsigned char* lds, int G, int wv) {
    const int tid = opaque_tid(wv), lane = tid & 63, n = tid >> 6, fr = lane & 15, fq = lane >> 4;
    bf16_t* P = (bf16_t*)(p.ws + WS_P); const bf16_t* GW = (const bf16_t*)(p.ws + WS_GW) + (size_t)l * 131072;
    f32x2* SUMM = (f32x2*)(p.ws + WS_SUMM); const float* CARRY = (const float*)(p.ws + WS_CARRY);
    LAS float* cw = (LAS float*)(lds + LR_CW_OFF);
    LAS bf16_t* hf = (LAS bf16_t*)(lds + LR_HF_OFF + n * 8192);
    LAS unsigned char* ul = lds + LR_U_OFF;
    bf16x8 idf[4];
    if constexpr (!FINAL) {
        for (int i = tid; i < 2560; i += 512) cw[i] = (i < 2048) ? p.conv_w[l * 2048 + i] : p.conv_b[l * 512 + (i - 2048)];
#pragma unroll
        for (int et = 0; et < 4; ++et) { const int idx = 16 * (et & 1) + fr - 8 * fq; const bool in = (idx >= 0) && (idx < 8);
            const unsigned v = in ? (0x3F80u << (16 * (idx & 1))) : 0u; u32x4 w; w.x = (in && (idx >> 1) == 0) ? v : 0u; w.y = (in && (idx >> 1) == 1) ? v : 0u; w.z = (in && (idx >> 1) == 2) ? v : 0u; w.w = (in && (idx >> 1) == 3) ? v : 0u;
            idf[et] = __builtin_bit_cast(bf16x8, w); }
    } else {
#pragma unroll
        for (int et = 0; et < 4; ++et) idf[et] = (bf16x8){0, 0, 0, 0, 0, 0, 0, 0};
    }
    for (int unit = blockIdx.x; unit < 2 * NCHUNK; unit += G) {
        const int b = unit >> 8, chunk = unit & 255;
        const size_t tb = (size_t)b * SEQ;
        if constexpr (!FINAL) {
            __syncthreads();
            {
                u32x4 ur[9]; const int r0 = tid >> 6, part = tid & 63;
                const bf16_t* ub = P + (tb + chunk * 64 - 2 + r0) * LDP + PC_U + 8 * part;
#pragma unroll
                for (int it = 0; it < 9; ++it) { const int row = r0 + 8 * it, sp = chunk * 64 + row - 2;
                    ur[it] = (u32x4){0u, 0u, 0u, 0u};
                    if (row < 67 && sp >= 0 && sp < SEQ) ur[it] = __builtin_nontemporal_load((const u32x4*)(ub + (size_t)(8 * it) * LDP)); }
#pragma unroll
                for (int it = 0; it < 9; ++it) { const int row = r0 + 8 * it;
                    if (row < 67) *(LAS u32x4*)(ul + row * LR_U_ROW + part * 16) = ur[it]; }
            }
            __syncthreads();
        }
        lru_sweep<FINAL, 0>(p, l, unit, n, lane, GW, CARRY, SUMM, cw, hf, ul, idf);
        asm volatile("" ::: "memory"); __builtin_amdgcn_sched_barrier(0);
        lru_sweep<FINAL, 1>(p, l, unit, n, lane, GW, CARRY, SUMM, cw, hf, ul, idf);
        if (FINAL) {
            asm volatile("s_waitcnt lgkmcnt(0)" ::: "memory");
            u32x4 zr[8];
#pragma unroll
            for (int it = 0; it < 8; ++it) zr[it] = *(const u32x4*)(P + (tb + chunk * 64 + it * 8 + (lane >> 3)) * LDP + PC_ZB + 64 * n + 8 * (lane & 7));
            __builtin_amdgcn_sched_barrier(0);
#pragma unroll
            for (int it = 0; it < 8; ++it) { const int row = it * 8 + (lane >> 3), c8 = lane & 7;
                const u32x4 hw = *(const LAS u32x4*)(hf + row * 64 + 8 * c8);
                bf16_t* zp = P + (tb + chunk * 64 + row) * LDP + PC_ZB + 64 * n + 8 * c8;
                const u32x4 z = zr[it];
                u32x4 w; w.x = cvt_pk_bf16(bf_lo(hw.x) * bf_lo(z.x), bf_hi(hw.x) * bf_hi(z.x)); w.y = cvt_pk_bf16(bf_lo(hw.y) * bf_lo(z.y), bf_hi(hw.y) * bf_hi(z.y));
                w.z = cvt_pk_bf16(bf_lo(hw.z) * bf_lo(z.z), bf_hi(hw.z) * bf_hi(z.z)); w.w = cvt_pk_bf16(bf_lo(hw.w) * bf_lo(z.w), bf_hi(hw.w) * bf_hi(z.w));
                *(u32x4*)zp = w; }
            asm volatile("s_waitcnt lgkmcnt(0)" ::: "memory");
        }
    }
    __syncthreads();
}
__device__ __forceinline__ void carry_phase(const Params& p, int G, int wv) {
    const int tid = opaque_tid(wv), lane = tid & 63, wave = tid >> 6;
    const f32x2* SUMM = (const f32x2*)(p.ws + WS_SUMM); float* CARRY = (float*)(p.ws + WS_CARRY);
    for (int seq = blockIdx.x * 8 + wave; seq < 2048; seq += G * 8) {
        const int ch = seq & 511, dir = (seq >> 9) & 1, b = seq >> 10;
        const f32x2* sp = SUMM + (size_t)seq * NCHUNK;
        f32x2 e[4];
#pragma unroll
        for (int k = 0; k < 4; ++k) { const int cp = 4 * lane + k; e[k] = sp[dir ? (NCHUNK - 1 - cp) : cp]; }
        float A = e[0].x, H = e[0].y;
#pragma unroll
        for (int k = 1; k < 4; ++k) { H = e[k].x * H + e[k].y; A = A * e[k].x; }
#pragma unroll
        for (int off = 1; off < 64; off <<= 1) { const float Ap = bperm(A, lane - off), Hp = bperm(H, lane - off);
            if (lane >= off) { H = A * Hp + H; A = A * Ap; } }
        float hin = bperm(H, lane - 1); if (lane == 0) hin = 0.f;
        float* cp0 = CARRY + (size_t)((b * 2 + dir) * NCHUNK) * 512 + ch;
#pragma unroll
        for (int k = 0; k < 4; ++k) { const int cp = 4 * lane + k; cp0[(size_t)(dir ? (NCHUNK - 1 - cp) : cp) * 512] = hin; hin = e[k].x * hin + e[k].y; }
    }
}


#define XB_TMO      128
#define XB_XCNT(j)  (256  + 64 * (j))
#define XB_XSUB(j)  (1280 + 64 * (j))
#define XB_XGEN(j)  (2304 + 64 * (j))
#define XB_TOP      3328
#define XB_TOPGEN   3392
#define XCD_BAR_WORDS 3456
#define XB_SPIN_CAP (1u << 22)
__device__ __forceinline__ unsigned xb_ld(unsigned* p)              { return __hip_atomic_load(p, __ATOMIC_RELAXED, __HIP_MEMORY_SCOPE_AGENT); }
__device__ __forceinline__ unsigned xb_add(unsigned* p, unsigned v) { return __hip_atomic_fetch_add(p, v, __ATOMIC_RELAXED, __HIP_MEMORY_SCOPE_AGENT); }
__device__ __forceinline__ unsigned xb_xcc_id() { return (unsigned)__builtin_amdgcn_s_getreg((3 << 11) | 20) & 0xFu; }
#define XB_SPIN(cond, bar) do { unsigned _sp = 0; while (cond) { __builtin_amdgcn_s_sleep(1); \
    if ((++_sp & 255u) == 0u) { if (xb_ld(&(bar)[XB_TMO])) break; if (_sp > XB_SPIN_CAP) { atomicAdd(&(bar)[XB_TMO], 1u); break; } } } } while (0)
struct XcdBarrier { unsigned* bar; unsigned x; volatile LAS unsigned* st; };
__device__ __forceinline__ XcdBarrier xcd_barrier_post(unsigned* bar, volatile LAS unsigned* st) {
    XcdBarrier b; b.bar = bar; b.x = xb_xcc_id(); b.st = st;
    if (threadIdx.x == 0) (void)xb_add(&bar[XB_XCNT(b.x)], 1u);
    return b;
}
__device__ __forceinline__ void xcd_barrier_complete(unsigned* bar, unsigned x, unsigned& nloc, unsigned& nx) {
    const unsigned G = gridDim.x * gridDim.y * gridDim.z;
    unsigned sum, cnt, mine, sp = 0u;
    for (;;) {
        sum = 0u; cnt = 0u; mine = 0u;
#pragma unroll
        for (unsigned j = 0; j < 16; ++j) { const unsigned c = xb_ld(&bar[XB_XCNT(j)]); sum += c; cnt += (c > 0u) ? 1u : 0u; mine = (j == x) ? c : mine; }
        if (sum == G) break;
        __builtin_amdgcn_s_sleep(1);
        if ((++sp & 255u) == 0u) { if (xb_ld(&bar[XB_TMO])) break; if (sp > XB_SPIN_CAP) { atomicAdd(&bar[XB_TMO], 1u); break; } }
    }
    nloc = mine > 0u ? mine : 1u; nx = cnt > 0u ? cnt : 1u;
}
__device__ __forceinline__ void xcd_barrier(const XcdBarrier& b, int wv) {
    asm volatile("s_waitcnt vmcnt(0)" ::: "memory");
    __syncthreads();
    if (wv == 0 && lane_id() == 0) {
        unsigned* bar = b.bar;
        __builtin_amdgcn_s_waitcnt(0);
        unsigned nloc = b.st[0], nx = b.st[1];
        if (nloc == 0u) { xcd_barrier_complete(bar, b.x, nloc, nx); b.st[0] = nloc; b.st[1] = nx; }
        const unsigned old = xb_add(&bar[XB_XSUB(b.x)], 1u);
        const unsigned gen = old / nloc;
        if (old + 1u == (gen + 1u) * nloc) {
            __builtin_amdgcn_fence(__ATOMIC_RELEASE, "agent");
            asm volatile("s_waitcnt vmcnt(0)" ::: "memory");
            const unsigned og = xb_add(&bar[XB_TOP], 1u);
            const unsigned tg = og / nx;
            if (og + 1u == (tg + 1u) * nx) xb_add(&bar[XB_TOPGEN], 1u);
            else XB_SPIN(xb_ld(&bar[XB_TOPGEN]) == tg, bar);
            __builtin_amdgcn_fence(__ATOMIC_ACQUIRE, "agent");
            xb_add(&bar[XB_XGEN(b.x)], 1u);
            asm volatile("s_waitcnt vmcnt(0)" ::: "memory");
        } else {
            XB_SPIN(xb_ld(&bar[XB_XGEN(b.x)]) == gen, bar);
            __builtin_amdgcn_fence(__ATOMIC_ACQUIRE, "agent");
            asm volatile("s_waitcnt vmcnt(0)" ::: "memory");
        }
    }
    __syncthreads();
}

__global__ void __launch_bounds__(512, 2) fwd_kernel(Params p) {
    extern __shared__ __attribute__((aligned(16))) unsigned char lds_raw[];
    LAS unsigned char* lds = (LAS unsigned char*)lds_raw;
    cg::grid_group grid = cg::this_grid();
    const int G = gridDim.x;
    const int wv = __builtin_amdgcn_readfirstlane(threadIdx.x >> 6);

    unsigned* barw = (unsigned*)(p.ws + WS_BAR);
    if (blockIdx.x == 0) for (int i = threadIdx.x; i < 4096 + NL * 128 * 64; i += 512) barw[i] = 0u;
    volatile LAS unsigned* bst = (volatile LAS unsigned*)(lds + LDS_BYTES - 16);
    if (threadIdx.x < 4) bst[threadIdx.x] = 0u;
    __syncthreads();
    p0_phase(p, lds, G, wv);
    grid.sync();
    const XcdBarrier xbar = xcd_barrier_post(barw, bst);
#pragma unroll 1
    for (int l = 0; l < NL; ++l) {
        unsigned char* wsl = p.ws; asm volatile("" : "+s"(wsl));
#define WIN ((bf16_t*)(wsl + WS_WIN))
#define WBR ((bf16_t*)(wsl + WS_WBR))
#define WOUT ((bf16_t*)(wsl + WS_WOUT))
#define XB ((bf16_t*)(wsl + WS_XB))
#define VT ((bf16_t*)(wsl + WS_VT))
#define P ((bf16_t*)(wsl + WS_P))
#if PROBE_GEMM
        for (int rep = 0; rep < 2; ++rep)
#endif
        {
            pg8::StaticOrder S; S.init(T, LDP, G, (int)blockIdx.x);
            pg8::Gemm g{XB, WIN + (size_t)l * DIN * D, T, LDP, D, D, D};
            pg8::EpiIn E{P, p.b_merge + l * 2 * D, (bf16_t*)(p.ws + WS_KX)};
            pg8::gemm_phase<pg8::EpiIn, 1024>(lds, g, S, E, wv);
            pg8::StaticOrder S2; S2.init(512, T, G, (int)blockIdx.x);
            pg8::Gemm g2{WIN + (size_t)l * DIN * D + (size_t)LDP * D, XB, 512, T, D, D, D};
            pg8::EpiPlain E2{VT, T};
            pg8::gemm_phase<pg8::EpiPlain, 1024>(lds, g2, S2, E2, wv);
        }
        xcd_barrier(xbar, wv);
        attn_phase(p, l, lds, G, wv);
        lru_phase<false>(p, l, lds, G, wv);
        xcd_barrier(xbar, wv);
        carry_phase(p, G, wv);
        xcd_barrier(xbar, wv);
        lru_phase<true>(p, l, lds, G, wv);
        xcd_barrier(xbar, wv);
#if PROBE_GEMM
        for (int rep = 0; rep < 2; ++rep)
#endif
        {
            pg8::StaticOrder S; S.init(T, D, G, (int)blockIdx.x);
            pg8::Gemm g{P, WBR + (size_t)l * D * D, T, D, D, LDP, D};
            pg8::EpiM E{P, XB};
            pg8::gemm_phase<pg8::EpiM, 4608>(lds, g, S, E, wv);
        }
        xcd_barrier(xbar, wv);
        {
            pg8::StaticOrder S; S.init(T, D, G, (int)blockIdx.x);
            pg8::Gemm g{XB, WOUT + (size_t)l * D * D, T, D, D, D, D};
            pg8::EpiRF E{p.x, p.out, p.ws, p.ln_g, p.ln_b, l, lds + MISC_OFF};
            pg8::gemm_phase<pg8::EpiRF, 1024>(lds, g, S, E, wv);
        }
        if (l + 1 < NL) xcd_barrier(xbar, wv);
    }
}

extern "C" void kernel_launch(void* const* d_in, const int* in_sizes, int n_in, void* d_out, int out_size, void* d_ws, size_t ws_size, hipStream_t stream) {
    static int grid_blocks = 0;
    if (grid_blocks == 0) {
        if (n_in != 16 || out_size != T * D || ws_size < WS_END) { fprintf(stderr, "kernel_launch: unexpected shapes (n_in %d out %d ws %zu need %zu)\n", n_in, out_size, ws_size, (size_t)WS_END); grid_blocks = -1; return; }
        int dev = 0, cus = 0, per_cu = 0;
        (void)hipGetDevice(&dev);
        (void)hipDeviceGetAttribute(&cus, hipDeviceAttributeMultiprocessorCount, dev);
        (void)hipFuncSetAttribute((const void*)fwd_kernel, hipFuncAttributeMaxDynamicSharedMemorySize, LDS_BYTES);
        (void)hipOccupancyMaxActiveBlocksPerMultiprocessor(&per_cu, (const void*)fwd_kernel, 512, LDS_BYTES);
        if (per_cu < 1) per_cu = 1;
        grid_blocks = cus;
        fprintf(stderr, "kernel_launch: grid %d (cus %d, occupancy query %d)\n", grid_blocks, cus, per_cu);
    }
    if (grid_blocks < 0) return;
    Params p{};
    p.x = (const float*)d_in[0]; p.emb_g = (const float*)d_in[1]; p.emb_b = (const float*)d_in[2]; p.w_in = (const float*)d_in[3]; p.rpb = (const float*)d_in[4];
    p.conv_w = (const float*)d_in[5]; p.conv_b = (const float*)d_in[6]; p.gate_w = (const float*)d_in[7]; p.gate_b = (const float*)d_in[8]; p.lam = (const float*)d_in[9];
    p.w_ba = (const float*)d_in[10]; p.w_bb = (const float*)d_in[11]; p.b_merge = (const float*)d_in[12]; p.w_out = (const float*)d_in[13]; p.ln_g = (const float*)d_in[14]; p.ln_b = (const float*)d_in[15];
    p.out = (float*)d_out; p.ws = (unsigned char*)d_ws;
    void* args[] = {&p};
    hipError_t e = hipLaunchCooperativeKernel((const void*)fwd_kernel, dim3(grid_blocks), dim3(512), args, LDS_BYTES, stream);
    if (e != hipSuccess) fprintf(stderr, "kernel_launch: cooperative launch failed: %s (grid %d)\n", hipGetErrorString(e), grid_blocks);
}
#undef WIN
#undef WBR
#undef WOUT
#undef XB
#undef VT
#undef P
```

```cpp
#include <hip/hip_runtime.h>
#include <hip/hip_cooperative_groups.h>
#include <cstdio>
#include <cstdint>
namespace cg = cooperative_groups;
#ifndef PROBE_ATTN
#define PROBE_ATTN 0
#endif
#ifndef PROBE_LRU
#define PROBE_LRU 0
#endif
#ifndef PROBE_GEMM
#define PROBE_GEMM 0
#endif

#define LAS __attribute__((address_space(3)))
typedef unsigned short bf16_t;
typedef short bf16x8 __attribute__((ext_vector_type(8)));
typedef float f32x4 __attribute__((ext_vector_type(4)));
typedef float f32x2 __attribute__((ext_vector_type(2)));
typedef unsigned u32x4 __attribute__((ext_vector_type(4)));
typedef unsigned u32x2 __attribute__((ext_vector_type(2)));

constexpr int T = 32768, D = 1024, SEQ = 16384, DIN = 5120, LDP = 4608, NL = 2;
constexpr int PC_Q = 0, PC_ZB = 512, PC_K = 1024, PC_ZA = 1536, PC_U = 2048, PC_G = 2560;
constexpr float ALPHA_F = 1.41421356237309515f;
constexpr float LN_EPS_F = 1e-5f;
constexpr int NCHUNK = 256;

constexpr size_t WS_WIN = 0;
constexpr size_t WS_WBR = WS_WIN + (size_t)NL * DIN * D * 2;
constexpr size_t WS_WOUT = WS_WBR + (size_t)NL * D * D * 2;
constexpr size_t WS_GW = WS_WOUT + (size_t)NL * D * D * 2;
constexpr size_t WS_SUMM = WS_GW + (size_t)NL * 2 * 2 * 8 * 64 * 64 * 2;
constexpr size_t WS_CARRY = WS_SUMM + (size_t)2 * 2 * 512 * NCHUNK * 8;
constexpr size_t WS_XB = WS_CARRY + (size_t)2 * 2 * NCHUNK * 512 * 4;
constexpr size_t WS_VT = WS_XB + (size_t)T * D * 2;
constexpr size_t WS_P = WS_VT + (size_t)512 * T * 2;
constexpr size_t WS_BAR = WS_P + (size_t)T * LDP * 2;
constexpr size_t WS_CNT = WS_BAR + 16384;
constexpr size_t WS_XCH = WS_CNT + (size_t)NL * 128 * 256;
constexpr size_t WS_STATS = WS_XCH + (size_t)T * 4 * 8;
constexpr size_t WS_KX = WS_STATS + (size_t)T * 8;
constexpr size_t WS_IDST = WS_KX + (size_t)T * 512 * 2;
constexpr size_t WS_STASH = WS_IDST + (size_t)T * 8 + 4 * D * 4;
constexpr size_t WS_END = WS_STASH + (size_t)T * 512 * 2;

constexpr int RING_BYTES = 131072, MISC_OFF = 131072, LDS_BYTES = 131072 + 16384;

__device__ __forceinline__ unsigned cvt_pk_bf16(float lo, float hi) { unsigned r; asm volatile("v_cvt_pk_bf16_f32 %0, %1, %2" : "=v"(r) : "v"(lo), "v"(hi)); return r; }
__device__ __forceinline__ float bf_lo(unsigned w) { return __uint_as_float(w << 16); }
__device__ __forceinline__ float bf_hi(unsigned w) { return __uint_as_float(w & 0xffff0000u); }
__device__ __forceinline__ float fast_rcp(float x) { return __builtin_amdgcn_rcpf(x); }
__device__ __forceinline__ float sigmoid_f(float x) { return fast_rcp(1.0f + __expf(-x)); }
__device__ __forceinline__ float silu_f(float x) { return x * sigmoid_f(x); }
__device__ __forceinline__ int lane_id() { int t; asm volatile("v_mbcnt_lo_u32_b32 %0, -1, 0\n\tv_mbcnt_hi_u32_b32 %0, -1, %0" : "=&v"(t)); return t; }
__device__ __forceinline__ int opaque_tid(int wv) { int t; asm volatile("v_mbcnt_lo_u32_b32 %0, -1, 0\n\tv_mbcnt_hi_u32_b32 %0, -1, %0\n\tv_lshl_or_b32 %0, %1, 6, %0" : "=&v"(t) : "s"(wv)); return t; }
template <int CTRL, int RMASK>
__device__ __forceinline__ float dpp_mov(float old_, float src) { return __int_as_float(__builtin_amdgcn_update_dpp(__float_as_int(old_), __float_as_int(src), CTRL, RMASK, 0xF, false)); }
__device__ __forceinline__ float wave_sum_dpp(float v) {
    v += dpp_mov<0xB1, 0xF>(v, v); v += dpp_mov<0x4E, 0xF>(v, v); v += dpp_mov<0x141, 0xF>(v, v); v += dpp_mov<0x140, 0xF>(v, v);
    v += dpp_mov<0x142, 0xA>(0.f, v); v += dpp_mov<0x143, 0xC>(0.f, v);
    return __int_as_float(__builtin_amdgcn_readlane(__float_as_int(v), 63));
}
__device__ __forceinline__ float bperm(float v, int src_lane) { return __int_as_float(__builtin_amdgcn_ds_bpermute(src_lane << 2, __float_as_int(v))); }
__device__ __forceinline__ float wave_sum(float v) {
#pragma unroll
    for (int o = 1; o < 64; o <<= 1) v += __shfl_xor(v, o);
    return v;
}

namespace pg8 {
constexpr int BM = 256, BK = 64, HALF = 128, HTB = HALF * BK * 2, STAGE_BYTES = 8 * HTB, NXCD = 8, WGM = 8;
__host__ __device__ __forceinline__ int lds_byte(int r, int c) { const int st = (r >> 4) * 2 + (c >> 5), rr = r & 15, cc = c & 31, ob = rr * 64 + cc * 2; return st * 1024 + (ob ^ (((ob >> 9) & 1) << 5)); }
__host__ __device__ __forceinline__ void stage_rc(int b, int& R, int& C) { const int st = b / 1024, sb = b % 1024, swz = sb ^ (((sb >> 9) & 1) << 5); R = (st >> 1) * 16 + swz / 64; C = (st & 1) * 32 + (swz % 64) / 2; }
__host__ __device__ __forceinline__ int perm32(int rho) { const int n = rho >> 4, i = rho & 15; return 8 * (i >> 2) + 4 * n + (i & 3); }
struct Unit { int pm, pn; };
struct Gemm { const bf16_t* A; const bf16_t* Bt; int M, N, K, lda, ldb; };
struct StaticOrder {
    int nM, nN, nwg, G, c;
    __device__ void init(int M, int N, int G_, int c_) { nM = M / BM; nN = N / BM; nwg = nM * nN; G = G_; c = c_; }
    __device__ bool next(int i, Unit& u) const {
        const long L = (long)i * G + c; if (L >= nwg) return false;
        int wgid = (int)L; { const int q = nwg / NXCD, r = nwg % NXCD, xcd = wgid % NXCD, off = wgid / NXCD; wgid = (xcd < r ? xcd * (q + 1) : r * (q + 1) + (xcd - r) * q) + off; }
        const int nig = WGM * nN, gid = wgid / nig, fm = gid * WGM, gsz = (nM - fm) < WGM ? (nM - fm) : WGM;
        u.pm = fm + ((wgid % nig) % gsz); u.pn = (wgid % nig) / gsz; return true;
    }
};
template <class Epi, int LDA, bool ALIGN_EPI = true>
__device__ __forceinline__ void gemm_phase(LAS unsigned char* lds, const Gemm g, const StaticOrder& S, const Epi& E, int wv) {
    const int tid = opaque_tid(wv), wid = __builtin_amdgcn_readfirstlane(tid >> 6), lane = tid & 63, wr = wid >> 2, wc = wid & 3, fr = lane & 15, fq = lane >> 4;
    constexpr int K = 1024, nt = K / BK, LDB = 1024;
    unsigned voffA[2], voffB[2];
#pragma unroll
    for (int i = 0; i < 2; ++i) { int R, C; stage_rc(tid * 16 + i * 8192, R, C); const int Rb = Epi::PERM ? ((R & ~31) + perm32(R & 31)) : R;
        voffA[i] = (unsigned)(R * LDA + C) * 2u; voffB[i] = (unsigned)(Rb * LDB + C) * 2u; }
    constexpr size_t kstep = (size_t)(BK * 2);
    constexpr size_t hstepA = (size_t)HALF * LDA * 2, hstepB = (size_t)HALF * LDB * 2;
    constexpr size_t tstepA = 2 * hstepA, tstepB = 2 * hstepB;
    const unsigned ldsw = (unsigned)wid * 1024u;
    const int aoff = lds_byte(wr * 64 + fr, fq * 8), boff = lds_byte(wc * 32 + fr, fq * 8);
#define PG8_SA(b, h) (((b) * 2 + (h)) * HTB)
#define PG8_SB(b, h) ((4 + (b) * 2 + (h)) * HTB)
#define PG8_STAGE(bufoff, gbase, voff) do { _Pragma("unroll") for (int _i = 0; _i < 2; ++_i) \
        __builtin_amdgcn_global_load_lds((const unsigned*)((const char*)(gbase) + (voff)[_i]), (LAS unsigned*)(lds + (bufoff) + ldsw + _i * 8192), 16, 0, 0); } while (0)
#define PG8_LDA(dst, b, h) do { _Pragma("unroll") for (int m = 0; m < 4; ++m) _Pragma("unroll") for (int k = 0; k < 2; ++k) dst[m][k] = *(const LAS bf16x8*)(lds + PG8_SA(b, h) + aoff + m * 2048 + k * 1024); } while (0)
#define PG8_LDB(dst, b, h) do { _Pragma("unroll") for (int n = 0; n < 2; ++n) _Pragma("unroll") for (int k = 0; k < 2; ++k) dst[n][k] = *(const LAS bf16x8*)(lds + PG8_SB(b, h) + boff + n * 2048 + k * 1024); } while (0)
#define PG8_MMA(ai, bj, At, Bt) do { __builtin_amdgcn_s_setprio(1); _Pragma("unroll") for (int m = 0; m < 4; ++m) _Pragma("unroll") for (int n = 0; n < 2; ++n) _Pragma("unroll") for (int k = 0; k < 2; ++k) \
        acc[ai][bj][m][n] = __builtin_amdgcn_mfma_f32_16x16x32_bf16(Bt[n][k], At[m][k], acc[ai][bj][m][n], 0, 0, 0); __builtin_amdgcn_s_setprio(0); } while (0)
#define PG8_WAIT_V(n) asm volatile("s_waitcnt vmcnt(" #n ")" ::: "memory")
#define PG8_WAIT_L(n) asm volatile("s_waitcnt lgkmcnt(" #n ")" ::: "memory")
#define PG8_BAR __builtin_amdgcn_s_barrier()
#define PG8_SCHED __builtin_amdgcn_sched_barrier(0)
    Unit cur, nxt; int ui = 0;
    if (!S.next(0, cur)) return;
    f32x4 acc[2][2][4][2];
#pragma unroll
    for (int a = 0; a < 2; ++a)
#pragma unroll
        for (int b = 0; b < 2; ++b)
#pragma unroll
            for (int m = 0; m < 4; ++m)
#pragma unroll
                for (int n = 0; n < 2; ++n) acc[a][b][m][n] = (f32x4){0.f, 0.f, 0.f, 0.f};
    bf16x8 At[4][2], B0[2][2], B1[2][2];
    const char* cA = (const char*)g.A + (size_t)cur.pm * tstepA; const char* cB = (const char*)g.Bt + (size_t)cur.pn * tstepB;
    PG8_STAGE(PG8_SB(0, 0), cB, voffB); PG8_STAGE(PG8_SB(0, 1), cB + hstepB, voffB); PG8_STAGE(PG8_SA(0, 0), cA, voffA); PG8_STAGE(PG8_SA(0, 1), cA + hstepA, voffA);
    if (wr == 1) PG8_BAR;
    PG8_WAIT_V(2); PG8_BAR;
    PG8_STAGE(PG8_SB(1, 0), cB + kstep, voffB); PG8_STAGE(PG8_SA(1, 0), cA + kstep, voffA); PG8_STAGE(PG8_SB(1, 1), cB + hstepB + kstep, voffB);
    PG8_WAIT_V(6); PG8_BAR;
    for (;;) {
        const bool has_next = S.next(ui + 1, nxt);
        const char* nA = has_next ? (const char*)g.A + (size_t)nxt.pm * tstepA : cA; const char* nB = has_next ? (const char*)g.Bt + (size_t)nxt.pn * tstepB : cB;
        for (int t = 0; t < nt; t += 2) {
            const bool last = (t == nt - 2);
            const char* a1 = cA + (size_t)(t + 1) * kstep;
            const char* a2 = last ? nA : cA + (size_t)(t + 2) * kstep; const char* b2 = last ? nB : cB + (size_t)(t + 2) * kstep;
            const char* a3 = a2 + kstep; const char* b3 = b2 + kstep;
            if constexpr (Epi::HAS_MID) { if (t == Epi::MID_T) E.mid(acc, cur, wr, wc, fr, fq); }
            PG8_LDB(B0, 0, 0); PG8_LDB(B1, 0, 1); PG8_SCHED; PG8_LDA(At, 0, 0); PG8_STAGE(PG8_SA(1, 1), a1 + hstepA, voffA);
            PG8_WAIT_V(8); PG8_WAIT_L(0); PG8_BAR; PG8_MMA(0, 0, At, B0); PG8_MMA(0, 1, At, B1); PG8_BAR; PG8_SCHED;
            PG8_LDA(At, 0, 1); PG8_STAGE(PG8_SB(0, 0), b2, voffB); PG8_STAGE(PG8_SB(0, 1), b2 + hstepB, voffB); PG8_STAGE(PG8_SA(0, 0), a2, voffA);
            PG8_WAIT_V(8); PG8_WAIT_L(0); PG8_BAR; PG8_MMA(1, 0, At, B0); PG8_MMA(1, 1, At, B1); PG8_BAR; PG8_SCHED;
            PG8_LDB(B0, 1, 0); PG8_LDB(B1, 1, 1); PG8_SCHED; PG8_LDA(At, 1, 0); PG8_STAGE(PG8_SA(0, 1), a2 + hstepA, voffA);
            PG8_WAIT_V(8); PG8_WAIT_L(0); PG8_BAR; PG8_MMA(0, 0, At, B0); PG8_MMA(0, 1, At, B1); PG8_BAR; PG8_SCHED;
            PG8_LDA(At, 1, 1); PG8_STAGE(PG8_SB(1, 0), b3, voffB); PG8_STAGE(PG8_SB(1, 1), b3 + hstepB, voffB); PG8_STAGE(PG8_SA(1, 0), a3, voffA);
            PG8_WAIT_V(8); PG8_WAIT_L(0); PG8_BAR; PG8_MMA(1, 0, At, B0); PG8_MMA(1, 1, At, B1); PG8_BAR; PG8_SCHED;
        }
        if constexpr (ALIGN_EPI) { if (wr == 0) PG8_BAR; }
        { int l2; asm volatile("v_mbcnt_lo_u32_b32 %0, -1, 0\n\tv_mbcnt_hi_u32_b32 %0, -1, %0" : "=&v"(l2));
          E(acc, cur, wr, wc, l2 & 15, l2 >> 4); }
        if (!has_next) break;
#pragma unroll
        for (int a = 0; a < 2; ++a)
#pragma unroll
            for (int b = 0; b < 2; ++b)
#pragma unroll
                for (int m = 0; m < 4; ++m)
#pragma unroll
                    for (int n = 0; n < 2; ++n) acc[a][b][m][n] = (f32x4){0.f, 0.f, 0.f, 0.f};
        cur = nxt; cA = nA; cB = nB; ++ui;
        if constexpr (ALIGN_EPI) { if (wr == 1) PG8_BAR; }
    }
    PG8_WAIT_V(0);
    if constexpr (!ALIGN_EPI) { if (wr == 0) PG8_BAR; }
    PG8_BAR;
#undef PG8_SA
#undef PG8_SB
#undef PG8_STAGE
#undef PG8_LDA
#undef PG8_LDB
#undef PG8_MMA
#undef PG8_WAIT_V
#undef PG8_WAIT_L
#undef PG8_BAR
#undef PG8_SCHED
}

__device__ __forceinline__ u32x4 pack8(f32x4 v0, f32x4 v1) { u32x4 w; w.x = cvt_pk_bf16(v0[0], v0[1]); w.y = cvt_pk_bf16(v0[2], v0[3]); w.z = cvt_pk_bf16(v1[0], v1[1]); w.w = cvt_pk_bf16(v1[2], v1[3]); return w; }

struct EpiIn {
    static constexpr bool PERM = true, HAS_MID = false; static constexpr int MID_T = 0, NVM = 16;
    bf16_t* P; const float* bm; bf16_t* KX;
    __device__ __forceinline__ void mid(f32x4 (&)[2][2][4][2], const Unit&, int, int, int, int) const {}
    __device__ __forceinline__ void operator()(const f32x4 (&acc)[2][2][4][2], const Unit& u, int wr, int wc, int fr, int fq) const {
        int row0 = u.pm * BM + wr * 64 + fr; asm volatile("" : "+v"(row0)); const int pn = u.pn;
        if (pn == 4 || pn == 5) {
#pragma unroll
            for (int bj = 0; bj < 2; ++bj) { const int c = (pn - 4) * BM + bj * HALF + wc * 32 + 8 * fq;
                bf16_t* kb = KX + ((size_t)((row0 >> 14) * 8 + (c >> 6)) * SEQ + (row0 & (SEQ - 1))) * 64 + (c & 63);
#pragma unroll
                for (int ai = 0; ai < 2; ++ai)
#pragma unroll
                    for (int m = 0; m < 4; ++m) *(u32x4*)(kb + (ai * HALF + m * 16) * 64) = pack8(acc[ai][bj][m][0], acc[ai][bj][m][1]); }
        } else if (pn < 10) {
            const bool act = (pn & 2) != 0;
            const int col0 = pn * BM + wc * 32 + 8 * fq;
#pragma unroll
            for (int ai = 0; ai < 2; ++ai)
#pragma unroll
                for (int m = 0; m < 4; ++m) { bf16_t* rowp = P + (size_t)(row0 + ai * HALF + m * 16) * LDP + col0;
#pragma unroll
                    for (int bj = 0; bj < 2; ++bj) { f32x4 v0 = acc[ai][bj][m][0], v1 = acc[ai][bj][m][1];
                        if (act) {
#pragma unroll
                            for (int j = 0; j < 4; ++j) { v0[j] = silu_f(v0[j]); v1[j] = silu_f(v1[j]); } }
                        *(u32x4*)(rowp + bj * HALF) = pack8(v0, v1); } }
        } else {
            const int j = pn - 10, gc = 128 * j + wc * 32 + 8 * fq;
            const f32x4 ba0 = *(const f32x4*)(bm + gc), ba1 = *(const f32x4*)(bm + gc + 4), bb0 = *(const f32x4*)(bm + 1024 + gc), bb1 = *(const f32x4*)(bm + 1024 + gc + 4);
            const int col0 = PC_G + 256 * j + wc * 32 + 8 * fq;
#pragma unroll
            for (int ai = 0; ai < 2; ++ai)
#pragma unroll
                for (int m = 0; m < 4; ++m) { bf16_t* rowp = P + (size_t)(row0 + ai * HALF + m * 16) * LDP + col0;
                    f32x4 ga0 = acc[ai][0][m][0] + ba0, ga1 = acc[ai][0][m][1] + ba1, gb0 = acc[ai][1][m][0] + bb0, gb1 = acc[ai][1][m][1] + bb1;
                    f32x4 r0, r1, s0, s1;
#pragma unroll
                    for (int q = 0; q < 4; ++q) {
                        const float ea0 = 1.0f + __expf(-ga0[q]), eb0 = 1.0f + __expf(-gb0[q]), ea1 = 1.0f + __expf(-ga1[q]), eb1 = 1.0f + __expf(-gb1[q]);
                        s0[q] = fast_rcp(eb0); s1[q] = fast_rcp(eb1); r0[q] = eb0 * fast_rcp(ea0); r1[q] = eb1 * fast_rcp(ea1); }
                    *(u32x4*)(rowp) = pack8(r0, r1); *(u32x4*)(rowp + HALF) = pack8(s0, s1); }
        }
    }
};
struct EpiPlain {
    static constexpr bool PERM = true, HAS_MID = false; static constexpr int MID_T = 0, NVM = 16;
    bf16_t* O; int ldc;
    __device__ __forceinline__ void mid(f32x4 (&)[2][2][4][2], const Unit&, int, int, int, int) const {}
    __device__ __forceinline__ void operator()(const f32x4 (&acc)[2][2][4][2], const Unit& u, int wr, int wc, int fr, int fq) const {
        int row0 = u.pm * BM + wr * 64 + fr; asm volatile("" : "+v"(row0)); const int col0 = u.pn * BM + wc * 32 + 8 * fq;
#pragma unroll
        for (int bj = 0; bj < 2; ++bj) { const int t = col0 + bj * HALF;
            bf16_t* vb = O + ((((size_t)((t >> 14) * 8 + (row0 >> 6)) * 256 + ((t >> 6) & 255)) * 64 + (row0 & 63)) * 64 + (t & 63));
#pragma unroll
            for (int ai = 0; ai < 2; ++ai)
#pragma unroll
                for (int m = 0; m < 4; ++m) *(u32x4*)(vb + (size_t)(2 * ai) * 256 * 4096 + m * 16 * 64) = pack8(acc[ai][bj][m][0], acc[ai][bj][m][1]); }
    }
};
struct EpiM {
    static constexpr bool PERM = true, HAS_MID = true; static constexpr int MID_T = 8, NVM = 16;
    const bf16_t* P; bf16_t* Mo;
    __device__ __forceinline__ void scale(f32x4 (&acc)[2][2][4][2], const Unit& u, int wr, int wc, int fr, int fq, int goff) const {
        int row0 = u.pm * BM + wr * 64 + fr; asm volatile("" : "+v"(row0));
#pragma unroll
        for (int ai = 0; ai < 2; ++ai) {
            u32x4 w[4][2];
#pragma unroll
            for (int m = 0; m < 4; ++m) { const bf16_t* rowp = P + (size_t)(row0 + ai * HALF + m * 16) * LDP + PC_G + goff + wc * 32 + 8 * fq;
#pragma unroll
                for (int bj = 0; bj < 2; ++bj) w[m][bj] = *(const u32x4*)(rowp + 256 * (2 * u.pn + bj)); }
            __builtin_amdgcn_sched_barrier(0);
#pragma unroll
            for (int m = 0; m < 4; ++m)
#pragma unroll
                for (int bj = 0; bj < 2; ++bj) { const u32x4 ww = w[m][bj];
                    f32x4& a0 = acc[ai][bj][m][0]; f32x4& a1 = acc[ai][bj][m][1];
                    a0[0] *= bf_lo(ww.x); a0[1] *= bf_hi(ww.x); a0[2] *= bf_lo(ww.y); a0[3] *= bf_hi(ww.y);
                    a1[0] *= bf_lo(ww.z); a1[1] *= bf_hi(ww.z); a1[2] *= bf_lo(ww.w); a1[3] *= bf_hi(ww.w); }
            __builtin_amdgcn_sched_barrier(0); }
    }
    __device__ __forceinline__ void mid(f32x4 (&acc)[2][2][4][2], const Unit& u, int wr, int wc, int fr, int fq) const { scale(acc, u, wr, wc, fr, fq, 0); }
    __device__ __forceinline__ void operator()(f32x4 (&acc)[2][2][4][2], const Unit& u, int wr, int wc, int fr, int fq) const {
        {
            int row0g = u.pm * BM + wr * 64 + fr; asm volatile("" : "+v"(row0g));
            u32x4 w[2][4][2];
#pragma unroll
            for (int ai = 0; ai < 2; ++ai)
#pragma unroll
                for (int m = 0; m < 4; ++m) { const bf16_t* rowp = P + (size_t)(row0g + ai * HALF + m * 16) * LDP + PC_G + HALF + wc * 32 + 8 * fq;
#pragma unroll
                    for (int bj = 0; bj < 2; ++bj) w[ai][m][bj] = *(const u32x4*)(rowp + 256 * (2 * u.pn + bj)); }
            asm volatile("" ::: "memory"); __builtin_amdgcn_sched_barrier(0);
#pragma unroll
            for (int ai = 0; ai < 2; ++ai)
#pragma unroll
                for (int m = 0; m < 4; ++m)
#pragma unroll
                    for (int bj = 0; bj < 2; ++bj) { const u32x4 ww = w[ai][m][bj];
                        f32x4& a0 = acc[ai][bj][m][0]; f32x4& a1 = acc[ai][bj][m][1];
                        a0[0] *= bf_lo(ww.x); a0[1] *= bf_hi(ww.x); a0[2] *= bf_lo(ww.y); a0[3] *= bf_hi(ww.y);
                        a1[0] *= bf_lo(ww.z); a1[1] *= bf_hi(ww.z); a1[2] *= bf_lo(ww.w); a1[3] *= bf_hi(ww.w); }
        }
        int row0 = u.pm * BM + wr * 64 + fr; asm volatile("" : "+v"(row0)); const int col0 = u.pn * BM + wc * 32 + 8 * fq;
#pragma unroll
        for (int ai = 0; ai < 2; ++ai)
#pragma unroll
            for (int m = 0; m < 4; ++m) { bf16_t* rowp = Mo + (size_t)(row0 + ai * HALF + m * 16) * D + col0;
#pragma unroll
                for (int bj = 0; bj < 2; ++bj) *(u32x4*)(rowp + bj * HALF) = pack8(acc[ai][bj][m][0], acc[ai][bj][m][1]); }
    }
};
struct EpiR {
    static constexpr bool PERM = false, HAS_MID = false; static constexpr int MID_T = 0, NVM = 32;
    const float* src; float* dst; const f32x2* stats; const float* g; const float* b;
    __device__ __forceinline__ void mid(f32x4 (&)[2][2][4][2], const Unit&, int, int, int, int) const {}
    __device__ __forceinline__ void operator()(const f32x4 (&acc)[2][2][4][2], const Unit& u, int wr, int wc, int fr, int fq) const {
        int row0 = u.pm * BM + wr * 64 + fr; asm volatile("" : "+v"(row0)); const int col0 = u.pn * BM + wc * 32 + 4 * fq;
        f32x4 gv[2][2], bv[2][2];
#pragma unroll
        for (int bj = 0; bj < 2; ++bj)
#pragma unroll
            for (int n = 0; n < 2; ++n) { gv[bj][n] = *(const f32x4*)(g + col0 + bj * HALF + n * 16) * ALPHA_F; bv[bj][n] = *(const f32x4*)(b + col0 + bj * HALF + n * 16) * ALPHA_F; }
#pragma unroll
        for (int ai = 0; ai < 2; ++ai)
#pragma unroll
            for (int mp = 0; mp < 2; ++mp) { f32x4 xr[2][2][2]; f32x2 st[2];
#pragma unroll
                for (int mi = 0; mi < 2; ++mi) { const int row = row0 + ai * HALF + (2 * mp + mi) * 16; st[mi] = stats[row]; const float* sp = src + (size_t)row * D + col0;
#pragma unroll
                    for (int bj = 0; bj < 2; ++bj)
#pragma unroll
                        for (int n = 0; n < 2; ++n) xr[mi][bj][n] = *(const f32x4*)(sp + bj * HALF + n * 16); }
                __builtin_amdgcn_sched_barrier(0);
#pragma unroll
                for (int mi = 0; mi < 2; ++mi) { const int row = row0 + ai * HALF + (2 * mp + mi) * 16; float* dp = dst + (size_t)row * D + col0;
#pragma unroll
                    for (int bj = 0; bj < 2; ++bj)
#pragma unroll
                        for (int n = 0; n < 2; ++n) *(f32x4*)(dp + bj * HALF + n * 16) = ((xr[mi][bj][n] - st[mi].x) * st[mi].y) * gv[bj][n] + bv[bj][n] + acc[ai][bj][2 * mp + mi][n]; }
                __builtin_amdgcn_sched_barrier(0); }
    }
};
struct EpiRF {
    static constexpr bool PERM = false, HAS_MID = false; static constexpr int MID_T = 0, NVM = 32; static constexpr bool RELAX = false;
    const float* xin; float* dst; unsigned char* ws; const float* lng; const float* lnb; int l; LAS unsigned char* misc;
    __device__ __forceinline__ void mid(f32x4 (&)[2][2][4][2], const Unit&, int, int, int, int) const {}
    __device__ __forceinline__ void operator()(f32x4 (&acc)[2][2][4][2], const Unit& u, int wr, int wc, int fr, int fq) const {
        const int tid = ((wr * 4 + wc) << 6) | (fq << 4) | fr;
        const float* src = (l == 0) ? xin : dst; const f32x2* stats = (const f32x2*)(ws + (l == 0 ? WS_STATS : WS_IDST));
        const float* g = (const float*)(ws + WS_IDST + (size_t)T * 8) + (l == 0 ? 2 * D : 0); const float* b = g + D;
        const float* g2 = lng + l * D; const float* b2 = lnb + l * D;
        unsigned long long* xch = (unsigned long long*)(ws + WS_XCH); unsigned* cnt = (unsigned*)(ws + WS_CNT) + (size_t)l * 128 * 64;
        bf16_t* dstb = (bf16_t*)(ws + WS_XB); const bool has_b = (l + 1 < NL);
        int row0 = u.pm * BM + wr * 64 + fr; asm volatile("" : "+v"(row0)); const int col0 = u.pn * BM + wc * 32 + 4 * fq;
        LAS f32x2* part = (LAS f32x2*)misc;
        LAS f32x2* stab = (LAS f32x2*)(misc + 8192);
        LAS float* aff = (LAS float*)(misc + 10240);
        const float affv = ((tid >> 8) ? b2 : g2)[u.pn * BM + (tid & 255)];
        const int lc0 = wc * 32 + 4 * fq;
#pragma unroll
        for (int ai = 0; ai < 2; ++ai) { float s1[4] = {0.f, 0.f, 0.f, 0.f}, s2[4] = {0.f, 0.f, 0.f, 0.f}; f32x2 st[4];
            int rb = row0 + ai * HALF; asm volatile("" : "+v"(rb));
#pragma unroll
            for (int m = 0; m < 4; ++m) st[m] = stats[rb + m * 16];
#pragma unroll
            for (int bj = 0; bj < 2; ++bj) { f32x4 xr[4][2], gv[2], bv[2];
#pragma unroll
                for (int n = 0; n < 2; ++n) { gv[n] = *(const f32x4*)(g + col0 + bj * HALF + n * 16); bv[n] = *(const f32x4*)(b + col0 + bj * HALF + n * 16); }
#pragma unroll
                for (int m = 0; m < 4; ++m)
#pragma unroll
                    for (int n = 0; n < 2; ++n) xr[m][n] = *(const f32x4*)(src + (size_t)(rb + m * 16) * D + col0 + bj * HALF + n * 16);
                asm volatile("" ::: "memory"); __builtin_amdgcn_sched_barrier(0);
                if (ai == 0 && bj == 0) aff[512 + tid] = affv;
#pragma unroll
                for (int m = 0; m < 4; ++m)
#pragma unroll
                    for (int n = 0; n < 2; ++n) { const f32x4 x = ((xr[m][n] - st[m].x) * st[m].y) * gv[n] + bv[n]; f32x4& a_ = acc[ai][bj][m][n];
#pragma unroll
                        for (int i = 0; i < 4; ++i) { const float v = __builtin_fmaf(x[i], ALPHA_F, a_[i]); a_[i] = v; s1[m] += v; s2[m] = __builtin_fmaf(v, v, s2[m]); } }
                asm volatile("" ::: "memory"); __builtin_amdgcn_sched_barrier(0); }
#pragma unroll
            for (int m = 0; m < 4; ++m) { float t1 = s1[m], t2 = s2[m];
                { const int ln_ = (fq << 4) | fr, a16 = (ln_ ^ 16) << 2, a32 = (ln_ ^ 32) << 2;
                  t1 += __int_as_float(__builtin_amdgcn_ds_bpermute(a16, __float_as_int(t1))); t1 += __int_as_float(__builtin_amdgcn_ds_bpermute(a32, __float_as_int(t1)));
                  t2 += __int_as_float(__builtin_amdgcn_ds_bpermute(a16, __float_as_int(t2))); t2 += __int_as_float(__builtin_amdgcn_ds_bpermute(a32, __float_as_int(t2))); }
                if (fq == 0) part[(ai * HALF + wr * 64 + m * 16 + fr) * 4 + wc] = (f32x2){t1, t2}; } }
        asm volatile("s_waitcnt lgkmcnt(0)" ::: "memory"); __builtin_amdgcn_s_barrier(); asm volatile("" ::: "memory");
        if (tid < 256) { const f32x2 a0 = part[tid * 4 + 0], a1 = part[tid * 4 + 1], a2 = part[tid * 4 + 2], a3 = part[tid * 4 + 3];
            const float S1 = (a0.x + a1.x) + (a2.x + a3.x), S2 = (a0.y + a1.y) + (a2.y + a3.y);
            const unsigned long long bits = ((unsigned long long)__float_as_uint(S2) << 32) | (unsigned long long)__float_as_uint(S1);
            __hip_atomic_store(xch + ((size_t)(u.pm * BM + tid)) * 4 + u.pn, bits, __ATOMIC_RELAXED, __HIP_MEMORY_SCOPE_AGENT); }
        asm volatile("s_waitcnt vmcnt(0)" ::: "memory"); __builtin_amdgcn_s_barrier(); asm volatile("" ::: "memory");
        if (tid == 0) {
            unsigned* c = cnt + 64 * u.pm;
            (void)__hip_atomic_fetch_add(c, 1u, __ATOMIC_RELAXED, __HIP_MEMORY_SCOPE_AGENT);
            unsigned sp = 0;
            while (__hip_atomic_load(c, __ATOMIC_RELAXED, __HIP_MEMORY_SCOPE_AGENT) < 4u) { __builtin_amdgcn_s_sleep(1); if (++sp > (1u << 22)) break; }
            __builtin_amdgcn_fence(__ATOMIC_ACQUIRE, "agent");
            asm volatile("s_waitcnt vmcnt(0)" ::: "memory");
        }
        asm volatile("" ::: "memory"); __builtin_amdgcn_s_barrier(); asm volatile("" ::: "memory");
        if (tid < 256) { float S1 = 0.f, S2 = 0.f;
#pragma unroll
            for (int k = 0; k < 4; ++k) { const unsigned long long bits = __hip_atomic_load(xch + ((size_t)(u.pm * BM + tid)) * 4 + k, __ATOMIC_RELAXED, __HIP_MEMORY_SCOPE_AGENT);
                S1 += __uint_as_float((unsigned)bits); S2 += __uint_as_float((unsigned)(bits >> 32)); }
            const float mean = S1 * (1.f / D), var = fmaxf(S2 * (1.f / D) - mean * mean, 0.f);
            stab[tid] = (f32x2){mean, 1.f / sqrtf(var + LN_EPS_F)}; }
        asm volatile("s_waitcnt lgkmcnt(0)" ::: "memory"); __builtin_amdgcn_s_barrier(); asm volatile("" ::: "memory");
        int l6 = tid & 63; asm volatile("" : "+v"(l6));
        const int fr6 = l6 & 15, lc6 = wc * 32 + 4 * (l6 >> 4), col6 = u.pn * BM + lc6;
#pragma unroll
        for (int ai = 0; ai < 2; ++ai) { f32x2 sn[4];
            const int rb = u.pm * BM + wr * 64 + fr6 + ai * HALF;
#pragma unroll
            for (int m = 0; m < 4; ++m) sn[m] = stab[ai * HALF + wr * 64 + m * 16 + fr6];
#pragma unroll
            for (int bj = 0; bj < 2; ++bj)
#pragma unroll
                for (int m = 0; m < 4; ++m)
#pragma unroll
                    for (int n = 0; n < 2; ++n) { const int lc = lc6 + bj * HALF + n * 16;
                        const f32x4 z = ((acc[ai][bj][m][n] - sn[m].x) * sn[m].y) * *(const LAS f32x4*)(aff + 512 + lc) + *(const LAS f32x4*)(aff + 768 + lc); const size_t off = (size_t)(rb + m * 16) * D + col6 + bj * HALF + n * 16;
                        *(f32x4*)(dst + off) = z;
                        if (has_b) { u32x2 w; w.x = cvt_pk_bf16(z[0], z[1]); w.y = cvt_pk_bf16(z[2], z[3]); *(u32x2*)(dstb + off) = w; } } }
        asm volatile("s_waitcnt lgkmcnt(0)" ::: "memory"); __builtin_amdgcn_s_barrier(); asm volatile("" ::: "memory");
    }
};
}

struct Params {
    const float *x, *emb_g, *emb_b, *w_in, *rpb, *conv_w, *conv_b, *gate_w, *gate_b, *lam, *w_ba, *w_bb, *b_merge, *w_out, *ln_g, *ln_b;
    float* out; unsigned char* ws;
};

__device__ __forceinline__ void transpose_item(const float* W, int ldw, int k0, int n0, bf16_t* dst, int ldd, float scale, LAS float* scr, int lane) {
    float v[32];
#pragma unroll
    for (int i = 0; i < 32; ++i) v[i] = W[(size_t)(k0 + 2 * i + (lane >> 5)) * ldw + n0 + (lane & 31)];
#pragma unroll
    for (int i = 0; i < 32; ++i) scr[(2 * i + (lane >> 5)) * 33 + (lane & 31)] = v[i];
    asm volatile("s_waitcnt lgkmcnt(0)" ::: "memory");
    const int c = lane & 7;
    float r[4][8];
#pragma unroll
    for (int j = 0; j < 4; ++j) { const LAS float* sp = scr + (8 * c) * 33 + (lane >> 3) + 8 * j;
#pragma unroll
        for (int q = 0; q < 8; ++q) r[j][q] = sp[q * 33]; }
#pragma unroll
    for (int j = 0; j < 4; ++j) { const int n = (lane >> 3) + 8 * j;
        u32x4 o; o.x = cvt_pk_bf16(r[j][0] * scale, r[j][1] * scale); o.y = cvt_pk_bf16(r[j][2] * scale, r[j][3] * scale);
        o.z = cvt_pk_bf16(r[j][4] * scale, r[j][5] * scale); o.w = cvt_pk_bf16(r[j][6] * scale, r[j][7] * scale);
        *(u32x4*)(dst + (size_t)n * ldd + 8 * c) = o; }
    asm volatile("s_waitcnt lgkmcnt(0)" ::: "memory");
}
__device__ __forceinline__ int win_dest_row(int n) {
    if (n < 512) return PC_Q + n;
    if (n < 1024) return PC_K + (n - 512);
    if (n < 1536) return LDP + (n - 1024);
    if (n < 2048) return PC_ZA + (n - 1536);
    if (n < 2560) return PC_U + (n - 2048);
    if (n < 3072) return PC_ZB + (n - 2560);
    if (n < 4096) { const int i = n - 3072; return PC_G + 256 * (i >> 7) + (i & 127); }
    { const int i = n - 4096; return PC_G + 256 * (i >> 7) + 128 + (i & 127); }
}
template <int R>
__device__ __forceinline__ void ln_rows(const float* xrow, size_t xstride, const float* g, const float* b, float* orow, bf16_t* brow, size_t ostride, f32x2* stats, int lane) {
    f32x4 v[R][4]; float s[R];
#pragma unroll
    for (int r = 0; r < R; ++r) { const f32x4* xr = (const f32x4*)(xrow + r * xstride) + lane; s[r] = 0.f;
#pragma unroll
        for (int j = 0; j < 4; ++j) v[r][j] = xr[64 * j]; }
#pragma unroll
    for (int r = 0; r < R; ++r)
#pragma unroll
        for (int j = 0; j < 4; ++j) s[r] += (v[r][j].x + v[r][j].y) + (v[r][j].z + v[r][j].w);
#pragma unroll
    for (int r = 0; r < R; ++r) s[r] = wave_sum_dpp(s[r]);
    float s2[R];
#pragma unroll
    for (int r = 0; r < R; ++r) { const float mean = s[r] * (1.f / D); s2[r] = 0.f;
#pragma unroll
        for (int j = 0; j < 4; ++j) { v[r][j] = v[r][j] - mean; s2[r] += (v[r][j].x * v[r][j].x + v[r][j].y * v[r][j].y) + (v[r][j].z * v[r][j].z + v[r][j].w * v[r][j].w); } }
#pragma unroll
    for (int r = 0; r < R; ++r) s2[r] = wave_sum_dpp(s2[r]);
    float rs_[R];
#pragma unroll
    for (int r = 0; r < R; ++r) { rs_[r] = 1.f / sqrtf(s2[r] * (1.f / D) + LN_EPS_F); if (stats && lane == 0) stats[r] = (f32x2){s[r] * (1.f / D), rs_[r]}; }
#pragma unroll
    for (int j = 0; j < 4; ++j) { const f32x4 gg = *((const f32x4*)g + lane + 64 * j), bb = *((const f32x4*)b + lane + 64 * j);
#pragma unroll
        for (int r = 0; r < R; ++r) { const float rstd = rs_[r];
            const f32x4 y = v[r][j] * rstd * gg + bb;
            if (orow) *((f32x4*)(orow + r * ostride) + lane + 64 * j) = y;
            if (brow) { u32x2 w; w.x = cvt_pk_bf16(y.x, y.y); w.y = cvt_pk_bf16(y.z, y.w); *((u32x2*)(brow + r * ostride) + lane + 64 * j) = w; } } }
}
__device__ __forceinline__ void p0_phase(const Params& p, LAS unsigned char* lds, int G, int wv) {
    const int tid = opaque_tid(wv), lane = tid & 63, wave = tid >> 6;
    LAS float* scr = (LAS float*)(lds + wave * 16384);
    const int gw = blockIdx.x * 8 + wave, NGW = G * 8;
    bf16_t* WIN = (bf16_t*)(p.ws + WS_WIN); bf16_t* WBR = (bf16_t*)(p.ws + WS_WBR); bf16_t* WOUT = (bf16_t*)(p.ws + WS_WOUT); bf16_t* GW = (bf16_t*)(p.ws + WS_GW);
    constexpr int I_IN = NL * 16 * 160, I_BR = NL * 8 * 32, I_OUT = NL * 16 * 32, I_GW = NL * 32 * 2;
    constexpr int NITEMS = I_IN + 2 * I_BR + I_OUT + I_GW;
    for (int it = gw; it < NITEMS; it += NGW) {
        int r = it;
        if (r < I_IN) { const int l = r / 2560, q = r % 2560, kb = q / 160, nb = q % 160, n0 = 32 * nb;
            transpose_item(p.w_in + (size_t)l * D * DIN, DIN, 64 * kb, n0, WIN + (size_t)l * DIN * D + (size_t)win_dest_row(n0) * D + 64 * kb, D, n0 < 512 ? 0.125f * 1.4426950408889634f : 1.0f, scr, lane); continue; }
        r -= I_IN;
        if (r < 2 * I_BR) { const int which = r / I_BR, q0 = r % I_BR, l = q0 / 256, q = q0 % 256, kb = q / 32, nb = q % 32;
            const float* W = (which ? p.w_bb : p.w_ba) + (size_t)l * 512 * D;
            transpose_item(W, D, 64 * kb, 32 * nb, WBR + (size_t)l * D * D + (size_t)(32 * nb) * D + which * 512 + 64 * kb, D, 1.0f, scr, lane); continue; }
        r -= 2 * I_BR;
        if (r < I_OUT) { const int l = r / 512, q = r % 512, kb = q / 32, nb = q % 32;
            transpose_item(p.w_out + (size_t)l * D * D, D, 64 * kb, 32 * nb, WOUT + (size_t)l * D * D + (size_t)(32 * nb) * D + 64 * kb, D, 1.0f, scr, lane); continue; }
        r -= I_OUT;
        { const int mat = r >> 1, nb = r & 1;
          transpose_item(p.gate_w + (size_t)mat * 4096, 64, 0, 32 * nb, GW + (size_t)mat * 4096 + (size_t)(32 * nb) * 64, 64, 1.0f, scr, lane); }
    }
    bf16_t* XB = (bf16_t*)(p.ws + WS_XB);
    { f32x2* ids = (f32x2*)(p.ws + WS_IDST); float* one = (float*)(p.ws + WS_IDST + (size_t)T * 8);
      for (int i2 = blockIdx.x * 512 + tid; i2 < T; i2 += G * 512) ids[i2] = (f32x2){0.f, 1.f};
      if (blockIdx.x == 0) for (int i2 = tid; i2 < 4 * D; i2 += 512) one[i2] = (i2 < D) ? 1.f : (i2 < 2 * D) ? 0.f : (i2 < 3 * D) ? p.emb_g[i2 - 2 * D] : p.emb_b[i2 - 3 * D]; }
    for (int m = 4 * gw; m < T; m += 4 * NGW) ln_rows<4>(p.x + (size_t)m * D, D, p.emb_g, p.emb_b, nullptr, XB + (size_t)m * D, D, (f32x2*)(p.ws + WS_STATS) + m, lane);
}
__device__ __forceinline__ void ln_phase(const Params& p, int l, int G, int wv) {
    const int tid = opaque_tid(wv), lane = tid & 63, wave = tid >> 6;
    const int gw = blockIdx.x * 8 + wave, NGW = G * 8;
    bf16_t* XB = (bf16_t*)(p.ws + WS_XB);
    const bool lastl = (l == NL - 1);
    for (int m = 4 * gw; m < T; m += 4 * NGW) ln_rows<4>(p.out + (size_t)m * D, D, p.ln_g + l * D, p.ln_b + l * D, lastl ? p.out + (size_t)m * D : nullptr, lastl ? nullptr : XB + (size_t)m * D, D, lastl ? nullptr : (f32x2*)(p.ws + WS_STATS) + m, lane);
}

constexpr int AT_K_OFF = 0, AT_V_OFF = 69120, AT_B_OFF = 138240, AT_NCH = 3840;
__device__ __forceinline__ void attn_decode(int unit, int& b, int& h, int& g, int& s) { g = unit & 3; s = (unit >> 2) & 31; h = (unit >> 7) & 7; b = unit >> 10; }
__device__ __forceinline__ void attn_issue(const bf16_t* KX, const bf16_t* VT, int unit, int tid, u32x4 (&kreg)[8], u32x4 (&vreg)[8]) {
    int b, h, g, s; attn_decode(unit, b, h, g, s);
    const int cb = (g == 0) ? 0 : (g == 1) ? 8 : (g == 2) ? 24 : 32;
    const int base = min(max(8 * s - 4, 0), 241);
#pragma unroll
    for (int it = 0; it < 8; ++it) { const int c = tid + 512 * it;
        if (c < AT_NCH) { const int row = c >> 8, rem = c & 255;
            kreg[it] = *(const u32x4*)(KX + ((size_t)(b * 8 + h) * SEQ + (base + row) * 64 + cb + (rem >> 3)) * 64 + 8 * (rem & 7));
            vreg[it] = *(const u32x4*)(VT + (((size_t)(b * 8 + h) * 256 + base + row) * 64 + (rem >> 2)) * 64 + cb + 8 * (rem & 3)); } }
}
__device__ __forceinline__ void attn_phase(const Params& p, int l, LAS unsigned char* lds, int G, int wv) {
    const int tid = opaque_tid(wv), lane = tid & 63, wid = tid >> 6, fr = lane & 15, fq = lane >> 4;
    bf16_t* P = (bf16_t*)(p.ws + WS_P); const bf16_t* VT = (const bf16_t*)(p.ws + WS_VT);
    LAS unsigned char* Kl = lds + AT_K_OFF; LAS unsigned char* Vl = lds + AT_V_OFF; LAS float* bl = (LAS float*)(lds + AT_B_OFF);
    u32x4 kreg[8], vreg[8];
    int unit = (G % 8 == 0) ? (int)(blockIdx.x & 7) * (G / 8) + (int)(blockIdx.x >> 3) : (int)blockIdx.x;
    asm volatile("" : "+s"(unit));
    const bf16_t* KX = (const bf16_t*)(p.ws + WS_KX);
    if (unit < 2048) attn_issue(KX, VT, unit, tid, kreg, vreg);
    for (; unit < 2048; unit += G) {
        int b, h, g, s; attn_decode(unit, b, h, g, s);
        const int cb = (g == 0) ? 0 : (g == 1) ? 8 : (g == 2) ? 24 : 32;
        const int base = min(max(8 * s - 4, 0), 241);
        const int r = 8 * s + wid, rs = min(max(r - 4, 0), 248), lr0 = rs - base;
        const int c = 16 * g + fr, cs = min(max(c - 8, 0), 48);
        const size_t tb = (size_t)b * SEQ, tq = tb + r * 64 + c;
        bf16x8 qf[2];
#pragma unroll
        for (int ks = 0; ks < 2; ++ks) qf[ks] = *(const bf16x8*)(P + tq * LDP + PC_Q + h * 64 + 32 * ks + 8 * fq);
        u32x2 zz[4];
#pragma unroll
        for (int dt = 0; dt < 4; ++dt) zz[dt] = *(const u32x2*)(P + tq * LDP + PC_ZA + h * 64 + 16 * dt + 4 * fq);
#pragma unroll
        for (int it = 0; it < 8; ++it) { const int ch = tid + 512 * it;
            if (ch < AT_NCH) { const int row = ch >> 8, rem = ch & 255;
                *(LAS u32x4*)(Kl + (row * 32 + (rem >> 3)) * 144 + (rem & 7) * 16) = kreg[it];
                LAS unsigned char* vd = Vl + (row * 64 + (rem >> 2)) * 72 + (rem & 3) * 16;
                *(LAS u32x2*)vd = (u32x2){vreg[it].x, vreg[it].y}; *(LAS u32x2*)(vd + 8) = (u32x2){vreg[it].z, vreg[it].w}; } }
        if (tid < 480) { const int drr = tid >> 5, cc = tid & 31; bl[tid] = (cc < 31) ? 1.4426950408889634f * p.rpb[(size_t)(l * 8 + h) * 465 + drr * 31 + cc] : -1e30f; }
        asm volatile("" :: "v"(qf[0]), "v"(qf[1]), "v"(zz[0]), "v"(zz[1]), "v"(zz[2]), "v"(zz[3]));
        __syncthreads();
        if (unit + G < 2048) attn_issue(KX, VT, unit + G, tid, kreg, vreg);
        f32x4 sc[8][2];
        bf16x8 kf[2][2][2][2];
        const LAS unsigned char* kbase = Kl + (lr0 * 32 + fr) * 144 + 16 * fq;
#define AT_LDK(buf, ip) do { _Pragma("unroll") for (int r_ = 0; r_ < 2; ++r_) _Pragma("unroll") for (int jt = 0; jt < 2; ++jt) { const LAS unsigned char* kp = kbase + ((2 * (ip) + r_) * 32 + 16 * jt) * 144; \
            kf[buf][r_][jt][0] = *(const LAS bf16x8*)kp; kf[buf][r_][jt][1] = *(const LAS bf16x8*)(kp + 64); } } while (0)
        AT_LDK(0, 0);
#pragma unroll
        for (int ip = 0; ip < 4; ++ip) {
            if (ip + 1 < 4) AT_LDK((ip + 1) & 1, ip + 1);
            __builtin_amdgcn_sched_barrier(0);
            __builtin_amdgcn_s_setprio(1);
#pragma unroll
            for (int r_ = 0; r_ < 2; ++r_)
#pragma unroll
                for (int jt = 0; jt < 2; ++jt) { f32x4 a = (f32x4){0.f, 0.f, 0.f, 0.f};
                    a = __builtin_amdgcn_mfma_f32_16x16x32_bf16(kf[ip & 1][r_][jt][0], qf[0], a, 0, 0, 0);
                    a = __builtin_amdgcn_mfma_f32_16x16x32_bf16(kf[ip & 1][r_][jt][1], qf[1], a, 0, 0, 0);
                    sc[2 * ip + r_][jt] = a; }
            __builtin_amdgcn_s_setprio(0);
            __builtin_amdgcn_sched_barrier(0);
        }
#undef AT_LDK
        const LAS float* bp[2][4];
#pragma unroll
        for (int jt = 0; jt < 2; ++jt)
#pragma unroll
            for (int q = 0; q < 4; ++q) { const int kc = cb + 16 * jt + 4 * fq + q; const bool valid = (kc >= cs) && (kc < cs + 16);
                bp[jt][q] = bl + (rs - r + 7) * 32 + (valid ? kc - c + 15 : 31); }
        float mx = -1e30f;
#pragma unroll
        for (int ih = 0; ih < 2; ++ih) {
            float bv_[4][2][4];
#pragma unroll
            for (int i = 0; i < 4; ++i)
#pragma unroll
                for (int jt = 0; jt < 2; ++jt)
#pragma unroll
                    for (int q = 0; q < 4; ++q) bv_[i][jt][q] = bp[jt][q][(4 * ih + i) * 32];
            __builtin_amdgcn_sched_barrier(0);
#pragma unroll
            for (int i = 0; i < 4; ++i)
#pragma unroll
                for (int jt = 0; jt < 2; ++jt)
#pragma unroll
                    for (int q = 0; q < 4; ++q) { const float v = sc[4 * ih + i][jt][q] + bv_[i][jt][q]; sc[4 * ih + i][jt][q] = v; mx = fmaxf(mx, v); }
        }
        mx = fmaxf(mx, bperm(mx, lane ^ 16)); mx = fmaxf(mx, bperm(mx, lane ^ 32));
        float sum = 0.f;
#pragma unroll
        for (int i = 0; i < 8; ++i)
#pragma unroll
            for (int jt = 0; jt < 2; ++jt)
#pragma unroll
                for (int q = 0; q < 4; ++q) { const float e = __builtin_amdgcn_exp2f(sc[i][jt][q] - mx); sc[i][jt][q] = e; sum += e; }
        sum += bperm(sum, lane ^ 16); sum += bperm(sum, lane ^ 32);
        const float inv = 1.0f / sum;
        f32x4 o[4];
#pragma unroll
        for (int dt = 0; dt < 4; ++dt) o[dt] = (f32x4){0.f, 0.f, 0.f, 0.f};
        u32x2 vr[2][4][2];
        const LAS unsigned char* vbase = Vl + (lr0 * 64 + fr) * 72 + 8 * fq;
#define AT_LDV(buf, i_) do { _Pragma("unroll") for (int dt = 0; dt < 4; ++dt) { const LAS unsigned char* vp = vbase + ((i_) * 64 + 16 * dt) * 72; \
            vr[buf][dt][0] = *(const LAS u32x2*)vp; vr[buf][dt][1] = *(const LAS u32x2*)(vp + 32); } } while (0)
        AT_LDV(0, 0);
#pragma unroll
        for (int i = 0; i < 8; ++i) {
            if (i + 1 < 8) AT_LDV((i + 1) & 1, i + 1);
            u32x4 pw; pw.x = cvt_pk_bf16(sc[i][0][0], sc[i][0][1]); pw.y = cvt_pk_bf16(sc[i][0][2], sc[i][0][3]); pw.z = cvt_pk_bf16(sc[i][1][0], sc[i][1][1]); pw.w = cvt_pk_bf16(sc[i][1][2], sc[i][1][3]);
            const bf16x8 pf = __builtin_bit_cast(bf16x8, pw);
            __builtin_amdgcn_sched_barrier(0);
            __builtin_amdgcn_s_setprio(1);
#pragma unroll
            for (int dt = 0; dt < 4; ++dt) {
                u32x4 vw; vw.x = vr[i & 1][dt][0].x; vw.y = vr[i & 1][dt][0].y; vw.z = vr[i & 1][dt][1].x; vw.w = vr[i & 1][dt][1].y;
                o[dt] = __builtin_amdgcn_mfma_f32_16x16x32_bf16(__builtin_bit_cast(bf16x8, vw), pf, o[dt], 0, 0, 0); }
            __builtin_amdgcn_s_setprio(0);
            __builtin_amdgcn_sched_barrier(0);
        }
#undef AT_LDV
#pragma unroll
        for (int dt = 0; dt < 4; ++dt) {
            const u32x2 z = zz[dt];
            u32x2 w; w.x = cvt_pk_bf16(o[dt][0] * inv * bf_lo(z.x), o[dt][1] * inv * bf_hi(z.x)); w.y = cvt_pk_bf16(o[dt][2] * inv * bf_lo(z.y), o[dt][3] * inv * bf_hi(z.y));
            *(u32x2*)(P + tq * LDP + PC_Q + h * 64 + 16 * dt + 4 * fq) = w; }
        __syncthreads();
    }
}

constexpr int LR_U_OFF = 0, LR_U_ROW = 1040, LR_HF_OFF = 67 * 1040, LR_CW_OFF = LR_HF_OFF + 65536, LR_END = LR_CW_OFF + 10240;
static_assert(LR_END <= LDS_BYTES - 16 && (LR_CW_OFF % 16) == 0 && (LR_HF_OFF % 16) == 0, "LRU LDS map");
__device__ __forceinline__ u32x2* stash_ptr(unsigned char* ws, int dir, int which, size_t blk, int lane) {
    if (dir == 0) return (u32x2*)(ws + WS_XB + (size_t)which * ((size_t)T * 512 * 2)) + blk * 64 + lane;
    if (which == 0) return (u32x2*)(ws + WS_STASH) + blk * 64 + lane;
    return (u32x2*)((bf16_t*)(ws + WS_P) + (blk >> 1) * LDP + PC_K + (blk & 1) * 256) + lane;
}
template <bool FINAL, int dir>
__device__ __forceinline__ void lru_sweep(const Params& p, int l, int unit, int n, int lane, const bf16_t* GW, const float* CARRY, f32x2* SUMM, LAS float* cw, LAS bf16_t* hf, LAS unsigned char* ul, const bf16x8 (&idf)[4]) {
    const int fr = lane & 15, fq = lane >> 4, b = unit >> 8, chunk = unit & 255;
    const size_t ub = ((size_t)unit * 8 + n) * 16;
    float h[4], At[4];
    if constexpr (!FINAL) {
        bf16x8 wf[2][4][2];
#pragma unroll
        for (int gm = 0; gm < 2; ++gm)
#pragma unroll
            for (int et = 0; et < 4; ++et)
#pragma unroll
                for (int ks = 0; ks < 2; ++ks) wf[gm][et][ks] = *(const bf16x8*)(GW + ((size_t)(((dir * 2 + gm) * 8 + n) * 64 + 16 * et + fr)) * 64 + 32 * ks + 8 * fq);
        float br[4], bi[4], ce[4];
        {   float g0[4], g1[4], lm[4];
#pragma unroll
            for (int et = 0; et < 4; ++et) { const int e = 64 * n + 16 * et + fr;
                g0[et] = p.gate_b[((l * 2 + dir) * 2 + 0) * 512 + e]; g1[et] = p.gate_b[((l * 2 + dir) * 2 + 1) * 512 + e]; lm[et] = p.lam[(l * 2 + dir) * 512 + e]; h[et] = 0.f; At[et] = 1.f; }
            __builtin_amdgcn_sched_barrier(0);
#pragma unroll
            for (int et = 0; et < 4; ++et) { br[et] = -1.4426950408889634f * g0[et]; bi[et] = -1.4426950408889634f * g1[et];
                ce[et] = -8.0f * 1.4426950408889634f * log1pf(__expf(-lm[et])); }
        }
#pragma unroll 1
        for (int tt = 0; tt < 4; ++tt) {
            const int tile = dir ? 3 - tt : tt;
            const int s0 = chunk * 64 + tile * 16;
            bf16x8 xf[2];
            LAS bf16x8* xcache = (LAS bf16x8*)hf + (tile * 2) * 64 + lane;
            if (dir == 0) {
#pragma unroll
                for (int ks = 0; ks < 2; ++ks) {
                    const int ch0 = 64 * n + 32 * ks + 8 * fq;
                    f32x4 a0 = *(const LAS f32x4*)(cw + 2048 + ch0), a1 = *(const LAS f32x4*)(cw + 2048 + ch0 + 4);
#pragma unroll
                    for (int tap = 0; tap < 4; ++tap) {
                        const u32x4 uw = *(const LAS u32x4*)(ul + (tile * 16 + fr + tap) * LR_U_ROW + ch0 * 2);
                        const f32x4 w0 = *(const LAS f32x4*)(cw + tap * 512 + ch0), w1 = *(const LAS f32x4*)(cw + tap * 512 + ch0 + 4);
                        a0[0] += bf_lo(uw.x) * w0[0]; a0[1] += bf_hi(uw.x) * w0[1]; a0[2] += bf_lo(uw.y) * w0[2]; a0[3] += bf_hi(uw.y) * w0[3];
                        a1[0] += bf_lo(uw.z) * w1[0]; a1[1] += bf_hi(uw.z) * w1[1]; a1[2] += bf_lo(uw.w) * w1[2]; a1[3] += bf_hi(uw.w) * w1[3]; }
                    xf[ks] = __builtin_bit_cast(bf16x8, pg8::pack8(a0, a1)); xcache[ks * 64] = xf[ks]; }
            } else { xf[0] = xcache[0]; xf[1] = xcache[64]; }
#pragma unroll
            for (int et = 0; et < 4; ++et) {
                if (et == 2) __builtin_amdgcn_sched_barrier(0);
                f32x4 gr = (f32x4){0.f, 0.f, 0.f, 0.f}, gi = gr, xc = gr;
                gr = __builtin_amdgcn_mfma_f32_16x16x32_bf16(xf[0], wf[0][et][0], gr, 0, 0, 0); gr = __builtin_amdgcn_mfma_f32_16x16x32_bf16(xf[1], wf[0][et][1], gr, 0, 0, 0);
                gi = __builtin_amdgcn_mfma_f32_16x16x32_bf16(xf[0], wf[1][et][0], gi, 0, 0, 0); gi = __builtin_amdgcn_mfma_f32_16x16x32_bf16(xf[1], wf[1][et][1], gi, 0, 0, 0);
                xc = __builtin_amdgcn_mfma_f32_16x16x32_bf16(xf[et >> 1], idf[et], xc, 0, 0, 0);
                float la[4], bx[4];
#pragma unroll
                for (int q = 0; q < 4; ++q) {
                    const float rg = fast_rcp(1.0f + __builtin_amdgcn_exp2f(__builtin_fmaf(gr[q], -1.4426950408889634f, br[et])));
                    const float ig = fast_rcp(1.0f + __builtin_amdgcn_exp2f(__builtin_fmaf(gi[q], -1.4426950408889634f, bi[et])));
                    la[q] = ce[et] * rg;
                    const float aq = __builtin_amdgcn_exp2f(la[q]);
                    float mult = __builtin_amdgcn_sqrtf(__builtin_fmaf(-aq, aq, 1.0f));
                    if (q == (dir ? 3 : 0)) { const int spos = s0 + 4 * fq + q; if (dir ? (spos == SEQ - 1) : (spos == 0)) mult = 1.0f; }
                    bx[q] = mult * ig * xc[q]; }
                u32x2 lw, bw; lw.x = cvt_pk_bf16(la[0], la[1]); lw.y = cvt_pk_bf16(la[2], la[3]); bw.x = cvt_pk_bf16(bx[0], bx[1]); bw.y = cvt_pk_bf16(bx[2], bx[3]);
                __builtin_nontemporal_store(lw, stash_ptr(p.ws, dir, 0, ub + tile * 4 + et, lane)); __builtin_nontemporal_store(bw, stash_ptr(p.ws, dir, 1, ub + tile * 4 + et, lane));
                float a[4];
                a[0] = __builtin_amdgcn_exp2f(bf_lo(lw.x)); a[1] = __builtin_amdgcn_exp2f(bf_hi(lw.x)); a[2] = __builtin_amdgcn_exp2f(bf_lo(lw.y)); a[3] = __builtin_amdgcn_exp2f(bf_hi(lw.y));
                bx[0] = bf_lo(bw.x); bx[1] = bf_hi(bw.x); bx[2] = bf_lo(bw.y); bx[3] = bf_hi(bw.y);
                const float A3 = (a[0] * a[1]) * (a[2] * a[3]);
                float B3;
                if (!dir) B3 = ((bx[0] * a[1] + bx[1]) * a[2] + bx[2]) * a[3] + bx[3];
                else B3 = ((bx[3] * a[2] + bx[2]) * a[1] + bx[1]) * a[0] + bx[0];
                float ag[4], bg[4];
#pragma unroll
                for (int k = 0; k < 4; ++k) { ag[k] = bperm(A3, 16 * k + fr); bg[k] = bperm(B3, 16 * k + fr); }
                if (!dir) { const float c0 = h[et], c1 = ag[0] * c0 + bg[0], c2 = ag[1] * c1 + bg[1], c3 = ag[2] * c2 + bg[2]; h[et] = ag[3] * c3 + bg[3]; }
                else { const float c3 = h[et], c2 = ag[3] * c3 + bg[3], c1 = ag[2] * c2 + bg[2], c0 = ag[1] * c1 + bg[1]; h[et] = ag[0] * c0 + bg[0]; }
                At[et] *= (ag[0] * ag[1]) * (ag[2] * ag[3]);
            }
        }
        if (fq == 0) {
#pragma unroll
            for (int et = 0; et < 4; ++et) SUMM[((size_t)((b * 2 + dir) * 512 + 64 * n + 16 * et + fr)) * NCHUNK + chunk] = (f32x2){At[et], h[et]}; }
    } else {
#pragma unroll
        for (int et = 0; et < 4; ++et) h[et] = CARRY[((size_t)((b * 2 + dir) * NCHUNK + chunk)) * 512 + 64 * n + 16 * et + fr];
        u32x2 nl[4], nb[4];
#pragma unroll
        for (int et = 0; et < 4; ++et) { const int t0 = dir ? 3 : 0; nl[et] = __builtin_nontemporal_load(stash_ptr(p.ws, dir, 0, ub + t0 * 4 + et, lane)); nb[et] = __builtin_nontemporal_load(stash_ptr(p.ws, dir, 1, ub + t0 * 4 + et, lane)); }
#pragma unroll 1
        for (int tt = 0; tt < 4; ++tt) {
            const int tile = dir ? 3 - tt : tt;
            u32x2 cl[4], cb[4];
#pragma unroll
            for (int et = 0; et < 4; ++et) { cl[et] = nl[et]; cb[et] = nb[et]; }
            if (tt + 1 < 4) { const int tn = dir ? tile - 1 : tile + 1;
#pragma unroll
                for (int et = 0; et < 4; ++et) { nl[et] = __builtin_nontemporal_load(stash_ptr(p.ws, dir, 0, ub + tn * 4 + et, lane)); nb[et] = __builtin_nontemporal_load(stash_ptr(p.ws, dir, 1, ub + tn * 4 + et, lane)); } }
#pragma unroll
            for (int et = 0; et < 4; ++et) {
                float a[4], bx[4];
                a[0] = __builtin_amdgcn_exp2f(bf_lo(cl[et].x)); a[1] = __builtin_amdgcn_exp2f(bf_hi(cl[et].x)); a[2] = __builtin_amdgcn_exp2f(bf_lo(cl[et].y)); a[3] = __builtin_amdgcn_exp2f(bf_hi(cl[et].y));
                bx[0] = bf_lo(cb[et].x); bx[1] = bf_hi(cb[et].x); bx[2] = bf_lo(cb[et].y); bx[3] = bf_hi(cb[et].y);
                const float A3 = (a[0] * a[1]) * (a[2] * a[3]);
                float B3;
                if (!dir) B3 = ((bx[0] * a[1] + bx[1]) * a[2] + bx[2]) * a[3] + bx[3];
                else B3 = ((bx[3] * a[2] + bx[2]) * a[1] + bx[1]) * a[0] + bx[0];
                float ag[4], bg[4];
#pragma unroll
                for (int k = 0; k < 4; ++k) { ag[k] = bperm(A3, 16 * k + fr); bg[k] = bperm(B3, 16 * k + fr); }
                float cin;
                if (!dir) { const float c0 = h[et], c1 = ag[0] * c0 + bg[0], c2 = ag[1] * c1 + bg[1], c3 = ag[2] * c2 + bg[2], c4 = ag[3] * c3 + bg[3];
                    cin = fq == 0 ? c0 : fq == 1 ? c1 : fq == 2 ? c2 : c3; h[et] = c4; }
                else { const float c3 = h[et], c2 = ag[3] * c3 + bg[3], c1 = ag[2] * c2 + bg[2], c0 = ag[1] * c1 + bg[1], cm = ag[0] * c0 + bg[0];
                    cin = fq == 3 ? c3 : fq == 2 ? c2 : fq == 1 ? c1 : c0; h[et] = cm; }
                float hv[4];
                if (!dir) { hv[0] = a[0] * cin + bx[0]; hv[1] = a[1] * hv[0] + bx[1]; hv[2] = a[2] * hv[1] + bx[2]; hv[3] = a[3] * hv[2] + bx[3]; }
                else { hv[3] = a[3] * cin + bx[3]; hv[2] = a[2] * hv[3] + bx[2]; hv[1] = a[1] * hv[2] + bx[1]; hv[0] = a[0] * hv[1] + bx[0]; }
#pragma unroll
                for (int q = 0; q < 4; ++q) { LAS bf16_t* hp = hf + (tile * 16 + 4 * fq + q) * 64 + 16 * et + fr;
                    float tot = hv[q]; if (dir) tot += __uint_as_float(((unsigned)*hp) << 16);
                    *hp = (bf16_t)(cvt_pk_bf16(tot, 0.f) & 0xffffu); }
            }
        }
    }
}
template <bool FINAL>
__device__ __forceinline__ void lru_phase(const Params& p, int l, LAS unsigned char* lds, int G, int wv) {
    const int tid = opaque_tid(wv), lane = tid & 63, n = tid >> 6, fr = lane & 15, fq = lane >> 4;
    bf16_t* P = (bf16_t*)(p.ws + WS_P); const bf16_t* GW = (const bf16_t*)(p.ws + WS_GW) + (size_t)l * 131072;
    f32x2* SUMM = (f32x2*)(p.ws + WS_SUMM); const float* CARRY = (const float*)(p.ws + WS_CARRY);
    LAS float* cw = (LAS float*)(lds + LR_CW_OFF);
    LAS bf16_t* hf = (LAS bf16_t*)(lds + LR_HF_OFF + n * 8192);
    LAS unsigned char* ul = lds + LR_U_OFF;
    bf16x8 idf[4];
    if constexpr (!FINAL) {
        for (int i = tid; i < 2560; i += 512) cw[i] = (i < 2048) ? p.conv_w[l * 2048 + i] : p.conv_b[l * 512 + (i - 2048)];
#pragma unroll
        for (int et = 0; et < 4; ++et) { const int idx = 16 * (et & 1) + fr - 8 * fq; const bool in = (idx >= 0) && (idx < 8);
            const unsigned v = in ? (0x3F80u << (16 * (idx & 1))) : 0u; u32x4 w; w.x = (in && (idx >> 1) == 0) ? v : 0u; w.y = (in && (idx >> 1) == 1) ? v : 0u; w.z = (in && (idx >> 1) == 2) ? v : 0u; w.w = (in && (idx >> 1) == 3) ? v : 0u;
            idf[et] = __builtin_bit_cast(bf16x8, w); }
    } else {
#pragma unroll
        for (int et = 0; et < 4; ++et) idf[et] = (bf16x8){0, 0, 0, 0, 0, 0, 0, 0};
    }
    for (int unit = (G % 8 == 0) ? (int)(blockIdx.x & 7) * (G / 8) + (int)(blockIdx.x >> 3) : (int)blockIdx.x; unit < 2 * NCHUNK; unit += G) {
        const int b = unit >> 8, chunk = unit & 255;
        const size_t tb = (size_t)b * SEQ;
        if constexpr (!FINAL) {
            __syncthreads();
            {
                u32x4 ur[9]; const int r0 = tid >> 6, part = tid & 63;
                const bf16_t* ub = P + (tb + chunk * 64 - 2 + r0) * LDP + PC_U + 8 * part;
#pragma unroll
                for (int it = 0; it < 9; ++it) { const int row = r0 + 8 * it, sp = chunk * 64 + row - 2;
                    ur[it] = (u32x4){0u, 0u, 0u, 0u};
                    if (row < 67 && sp >= 0 && sp < SEQ) ur[it] = *(const u32x4*)(ub + (size_t)(8 * it) * LDP); }
#pragma unroll
                for (int it = 0; it < 9; ++it) { const int row = r0 + 8 * it;
                    if (row < 67) *(LAS u32x4*)(ul + row * LR_U_ROW + part * 16) = ur[it]; }
            }
            __syncthreads();
        }
        lru_sweep<FINAL, 0>(p, l, unit, n, lane, GW, CARRY, SUMM, cw, hf, ul, idf);
        asm volatile("" ::: "memory"); __builtin_amdgcn_sched_barrier(0);
        lru_sweep<FINAL, 1>(p, l, unit, n, lane, GW, CARRY, SUMM, cw, hf, ul, idf);
        if (FINAL) {
            asm volatile("s_waitcnt lgkmcnt(0)" ::: "memory");
            u32x4 zr[8];
#pragma unroll
            for (int it = 0; it < 8; ++it) zr[it] = *(const u32x4*)(P + (tb + chunk * 64 + it * 8 + (lane >> 3)) * LDP + PC_ZB + 64 * n + 8 * (lane & 7));
            __builtin_amdgcn_sched_barrier(0);
#pragma unroll
            for (int it = 0; it < 8; ++it) { const int row = it * 8 + (lane >> 3), c8 = lane & 7;
                const u32x4 hw = *(const LAS u32x4*)(hf + row * 64 + 8 * c8);
                bf16_t* zp = P + (tb + chunk * 64 + row) * LDP + PC_ZB + 64 * n + 8 * c8;
                const u32x4 z = zr[it];
                u32x4 w; w.x = cvt_pk_bf16(bf_lo(hw.x) * bf_lo(z.x), bf_hi(hw.x) * bf_hi(z.x)); w.y = cvt_pk_bf16(bf_lo(hw.y) * bf_lo(z.y), bf_hi(hw.y) * bf_hi(z.y));
                w.z = cvt_pk_bf16(bf_lo(hw.z) * bf_lo(z.z), bf_hi(hw.z) * bf_hi(z.z)); w.w = cvt_pk_bf16(bf_lo(hw.w) * bf_lo(z.w), bf_hi(hw.w) * bf_hi(z.w));
                *(u32x4*)zp = w; }
            asm volatile("s_waitcnt lgkmcnt(0)" ::: "memory");
        }
    }
    __syncthreads();
}
__device__ __forceinline__ void carry_phase(const Params& p, int G, int wv) {
    const int tid = opaque_tid(wv), lane = tid & 63, wave = tid >> 6;
    const f32x2* SUMM = (const f32x2*)(p.ws + WS_SUMM); float* CARRY = (float*)(p.ws + WS_CARRY);
    for (int seq = blockIdx.x * 8 + wave; seq < 2048; seq += G * 8) {
        const int ch = seq & 511, dir = (seq >> 9) & 1, b = seq >> 10;
        const f32x2* sp = SUMM + (size_t)seq * NCHUNK;
        f32x2 e[4];
#pragma unroll
        for (int k = 0; k < 4; ++k) { const int cp = 4 * lane + k; e[k] = sp[dir ? (NCHUNK - 1 - cp) : cp]; }
        float A = e[0].x, H = e[0].y;
#pragma unroll
        for (int k = 1; k < 4; ++k) { H = e[k].x * H + e[k].y; A = A * e[k].x; }
#pragma unroll
        for (int off = 1; off < 64; off <<= 1) { const float Ap = bperm(A, lane - off), Hp = bperm(H, lane - off);
            if (lane >= off) { H = A * Hp + H; A = A * Ap; } }
        float hin = bperm(H, lane - 1); if (lane == 0) hin = 0.f;
        float* cp0 = CARRY + (size_t)((b * 2 + dir) * NCHUNK) * 512 + ch;
#pragma unroll
        for (int k = 0; k < 4; ++k) { const int cp = 4 * lane + k; cp0[(size_t)(dir ? (NCHUNK - 1 - cp) : cp) * 512] = hin; hin = e[k].x * hin + e[k].y; }
    }
}


#define XB_TMO      128
#define XB_XCNT(j)  (256  + 64 * (j))
#define XB_XSUB(j)  (1280 + 64 * (j))
#define XB_XGEN(j)  (2304 + 64 * (j))
#define XB_TOP      3328
#define XB_TOPGEN   3392
#define XCD_BAR_WORDS 3456
#define XB_SPIN_CAP (1u << 22)
__device__ __forceinline__ unsigned xb_ld(unsigned* p)              { return __hip_atomic_load(p, __ATOMIC_RELAXED, __HIP_MEMORY_SCOPE_AGENT); }
__device__ __forceinline__ unsigned xb_add(unsigned* p, unsigned v) { return __hip_atomic_fetch_add(p, v, __ATOMIC_RELAXED, __HIP_MEMORY_SCOPE_AGENT); }
__device__ __forceinline__ unsigned xb_xcc_id() { return (unsigned)__builtin_amdgcn_s_getreg((3 << 11) | 20) & 0xFu; }
#define XB_SPIN(cond, bar) do { unsigned _sp = 0; while (cond) { __builtin_amdgcn_s_sleep(1); \
    if ((++_sp & 255u) == 0u) { if (xb_ld(&(bar)[XB_TMO])) break; if (_sp > XB_SPIN_CAP) { atomicAdd(&(bar)[XB_TMO], 1u); break; } } } } while (0)
struct XcdBarrier { unsigned* bar; unsigned x; volatile LAS unsigned* st; };
__device__ __forceinline__ XcdBarrier xcd_barrier_post(unsigned* bar, volatile LAS unsigned* st) {
    XcdBarrier b; b.bar = bar; b.x = xb_xcc_id(); b.st = st;
    if (threadIdx.x == 0) (void)xb_add(&bar[XB_XCNT(b.x)], 1u);
    return b;
}
__device__ __forceinline__ void xcd_barrier_complete(unsigned* bar, unsigned x, unsigned& nloc, unsigned& nx) {
    const unsigned G = gridDim.x * gridDim.y * gridDim.z;
    unsigned sum, cnt, mine, sp = 0u;
    for (;;) {
        sum = 0u; cnt = 0u; mine = 0u;
#pragma unroll
        for (unsigned j = 0; j < 16; ++j) { const unsigned c = xb_ld(&bar[XB_XCNT(j)]); sum += c; cnt += (c > 0u) ? 1u : 0u; mine = (j == x) ? c : mine; }
        if (sum == G) break;
        __builtin_amdgcn_s_sleep(1);
        if ((++sp & 255u) == 0u) { if (xb_ld(&bar[XB_TMO])) break; if (sp > XB_SPIN_CAP) { atomicAdd(&bar[XB_TMO], 1u); break; } }
    }
    nloc = mine > 0u ? mine : 1u; nx = cnt > 0u ? cnt : 1u;
}
__device__ __forceinline__ void xcd_barrier(const XcdBarrier& b, int wv) {
    asm volatile("s_waitcnt vmcnt(0)" ::: "memory");
    __syncthreads();
    if (wv == 0 && lane_id() == 0) {
        unsigned* bar = b.bar;
        __builtin_amdgcn_s_waitcnt(0);
        unsigned nloc = b.st[0], nx = b.st[1];
        if (nloc == 0u) { xcd_barrier_complete(bar, b.x, nloc, nx); b.st[0] = nloc; b.st[1] = nx; }
        const unsigned old = xb_add(&bar[XB_XSUB(b.x)], 1u);
        const unsigned gen = old / nloc;
        if (old + 1u == (gen + 1u) * nloc) {
            __builtin_amdgcn_fence(__ATOMIC_RELEASE, "agent");
            asm volatile("s_waitcnt vmcnt(0)" ::: "memory");
            const unsigned og = xb_add(&bar[XB_TOP], 1u);
            const unsigned tg = og / nx;
            if (og + 1u == (tg + 1u) * nx) xb_add(&bar[XB_TOPGEN], 1u);
            else XB_SPIN(xb_ld(&bar[XB_TOPGEN]) == tg, bar);
            __builtin_amdgcn_fence(__ATOMIC_ACQUIRE, "agent");
            xb_add(&bar[XB_XGEN(b.x)], 1u);
            asm volatile("s_waitcnt vmcnt(0)" ::: "memory");
        } else {
            XB_SPIN(xb_ld(&bar[XB_XGEN(b.x)]) == gen, bar);
            __builtin_amdgcn_fence(__ATOMIC_ACQUIRE, "agent");
            asm volatile("s_waitcnt vmcnt(0)" ::: "memory");
        }
    }
    __syncthreads();
}

__global__ void __launch_bounds__(512, 2) fwd_kernel(Params p) {
    extern __shared__ __attribute__((aligned(16))) unsigned char lds_raw[];
    LAS unsigned char* lds = (LAS unsigned char*)lds_raw;
    cg::grid_group grid = cg::this_grid();
    const int G = gridDim.x;
    const int wv = __builtin_amdgcn_readfirstlane(threadIdx.x >> 6);

    unsigned* barw = (unsigned*)(p.ws + WS_BAR);
    if (blockIdx.x == 0) for (int i = threadIdx.x; i < 4096 + NL * 128 * 64; i += 512) barw[i] = 0u;
    volatile LAS unsigned* bst = (volatile LAS unsigned*)(lds + LDS_BYTES - 16);
    if (threadIdx.x < 4) bst[threadIdx.x] = 0u;
    __syncthreads();
    p0_phase(p, lds, G, wv);
    grid.sync();
    const XcdBarrier xbar = xcd_barrier_post(barw, bst);
#pragma unroll 1
    for (int l = 0; l < NL; ++l) {
        unsigned char* wsl = p.ws; asm volatile("" : "+s"(wsl));
#define WIN ((bf16_t*)(wsl + WS_WIN))
#define WBR ((bf16_t*)(wsl + WS_WBR))
#define WOUT ((bf16_t*)(wsl + WS_WOUT))
#define XB ((bf16_t*)(wsl + WS_XB))
#define VT ((bf16_t*)(wsl + WS_VT))
#define P ((bf16_t*)(wsl + WS_P))
#if PROBE_GEMM
        for (int rep = 0; rep < 2; ++rep)
#endif
        {
            pg8::StaticOrder S; S.init(T, LDP, G, (int)blockIdx.x);
            pg8::Gemm g{XB, WIN + (size_t)l * DIN * D, T, LDP, D, D, D};
            pg8::EpiIn E{P, p.b_merge + l * 2 * D, (bf16_t*)(p.ws + WS_KX)};
            pg8::gemm_phase<pg8::EpiIn, 1024>(lds, g, S, E, wv);
            pg8::StaticOrder S2; S2.init(512, T, G, (int)blockIdx.x);
            pg8::Gemm g2{WIN + (size_t)l * DIN * D + (size_t)LDP * D, XB, 512, T, D, D, D};
            pg8::EpiPlain E2{VT, T};
            pg8::gemm_phase<pg8::EpiPlain, 1024>(lds, g2, S2, E2, wv);
        }
        xcd_barrier(xbar, wv);
        attn_phase(p, l, lds, G, wv);
        lru_phase<false>(p, l, lds, G, wv);
        xcd_barrier(xbar, wv);
        carry_phase(p, G, wv);
        xcd_barrier(xbar, wv);
        lru_phase<true>(p, l, lds, G, wv);
        xcd_barrier(xbar, wv);
#if PROBE_GEMM
        for (int rep = 0; rep < 2; ++rep)
#endif
        {
            pg8::StaticOrder S; S.init(T, D, G, (int)blockIdx.x);
            pg8::Gemm g{P, WBR + (size_t)l * D * D, T, D, D, LDP, D};
            pg8::EpiM E{P, XB};
            pg8::gemm_phase<pg8::EpiM, 4608>(lds, g, S, E, wv);
        }
        xcd_barrier(xbar, wv);
        {
            pg8::StaticOrder S; S.init(T, D, G, (int)blockIdx.x);
            pg8::Gemm g{XB, WOUT + (size_t)l * D * D, T, D, D, D, D};
            pg8::EpiRF E{p.x, p.out, p.ws, p.ln_g, p.ln_b, l, lds + MISC_OFF};
            pg8::gemm_phase<pg8::EpiRF, 1024>(lds, g, S, E, wv);
        }
        if (l + 1 < NL) xcd_barrier(xbar, wv);
    }
}

extern "C" void kernel_launch(void* const* d_in, const int* in_sizes, int n_in, void* d_out, int out_size, void* d_ws, size_t ws_size, hipStream_t stream) {
    static int grid_blocks = 0;
    if (grid_blocks == 0) {
        if (n_in != 16 || out_size != T * D || ws_size < WS_END) { fprintf(stderr, "kernel_launch: unexpected shapes (n_in %d out %d ws %zu need %zu)\n", n_in, out_size, ws_size, (size_t)WS_END); grid_blocks = -1; return; }
        int dev = 0, cus = 0, per_cu = 0;
        (void)hipGetDevice(&dev);
        (void)hipDeviceGetAttribute(&cus, hipDeviceAttributeMultiprocessorCount, dev);
        (void)hipFuncSetAttribute((const void*)fwd_kernel, hipFuncAttributeMaxDynamicSharedMemorySize, LDS_BYTES);
        (void)hipOccupancyMaxActiveBlocksPerMultiprocessor(&per_cu, (const void*)fwd_kernel, 512, LDS_BYTES);
        if (per_cu < 1) per_cu = 1;
        grid_blocks = cus;
        fprintf(stderr, "kernel_launch: grid %d (cus %d, occupancy query %d)\n", grid_blocks, cus, per_cu);
    }
    if (grid_blocks < 0) return;
    Params p{};
    p.x = (const float*)d_in[0]; p.emb_g = (const float*)d_in[1]; p.emb_b = (const float*)d_in[2]; p.w_in = (const float*)d_in[3]; p.rpb = (const float*)d_in[4];
    p.conv_w = (const float*)d_in[5]; p.conv_b = (const float*)d_in[6]; p.gate_w = (const float*)d_in[7]; p.gate_b = (const float*)d_in[8]; p.lam = (const float*)d_in[9];
    p.w_ba = (const float*)d_in[10]; p.w_bb = (const float*)d_in[11]; p.b_merge = (const float*)d_in[12]; p.w_out = (const float*)d_in[13]; p.ln_g = (const float*)d_in[14]; p.ln_b = (const float*)d_in[15];
    p.out = (float*)d_out; p.ws = (unsigned char*)d_ws;
    void* args[] = {&p};
    hipError_t e = hipLaunchCooperativeKernel((const void*)fwd_kernel, dim3(grid_blocks), dim3(512), args, LDS_BYTES, stream);
    if (e != hipSuccess) fprintf(stderr, "kernel_launch: cooperative launch failed: %s (grid %d)\n", hipGetErrorString(e), grid_blocks);
}
#undef WIN
#undef WBR
#undef WOUT
#undef XB
#undef VT
#undef P
```
